# Optimizing an MI355X kernel written in HIP

```python
import math
import jax
import jax.numpy as jnp
from jax import lax
import numpy as np

D_MODEL = 1024
BATCH = 8
SEQ = 8192
DEPTH = 1
DEC_BATCH = 8
DEC_SEQ = 4096
PAST_LEN = 128

EPS = 1e-6
HEAD_DIM = D_MODEL // 16
N_HEADS = 12
DILATED_GROUPS = ((128, 1), (512, 4), (2048, 16))
HEADS_PER_GROUP = N_HEADS // len(DILATED_GROUPS)
ATTN_WIDTH = N_HEADS * HEAD_DIM
ATTN_OUT_WIDTH = HEADS_PER_GROUP * HEAD_DIM
NUM_BUCKETS = 32
MAX_DISTANCE = 1024
NEG_INF = -1e30
D_HYENA = 3 * D_MODEL // 4
SHORT_CONV = 3
FILTER_BANDS = 16
FILTER_EMB = 1 + 2 * FILTER_BANDS
FILTER_HIDDEN = 64
DECAY_TARGET = 1e-2
FAST_DECAY_PCT = 0.3
SLOW_DECAY_PCT = 1.5
N_BRANCHES = 2
D_FF = 4 * D_MODEL
IN_PROJ_WIDTH = 3 * D_HYENA + 3 * ATTN_WIDTH + N_BRANCHES * D_MODEL

kernel_name = 'hyena_dilated_attn_encoder'


def rmsnorm(x, g):
    xf = x.astype(jnp.float32)
    y = xf * lax.rsqrt(jnp.mean(xf * xf, axis=-1, keepdims=True) + EPS)
    return (y * g.astype(jnp.float32)).astype(x.dtype)


def t5_bucket(rel):
    half = NUM_BUCKETS // 2
    max_exact = half // 2
    n = jnp.abs(rel)
    ret = jnp.where(rel > 0, half, 0)
    large = max_exact + (jnp.log(jnp.maximum(n, 1).astype(jnp.float32) / max_exact)
                         / math.log(MAX_DISTANCE / max_exact) * (half - max_exact)).astype(jnp.int32)
    large = jnp.minimum(large, half - 1)
    return ret + jnp.where(n < max_exact, n, large)


def banded_attention(q, k, v, bias_vec, radius):
    blk = radius
    S, hd = q.shape[-2], q.shape[-1]
    nb = -(-S // blk)
    sp = nb * blk
    lead = q.shape[:-2]
    def pad_cfg(lo, hi):
        return [(0, 0)] * len(lead) + [(lo, hi), (0, 0)]
    qb = jnp.pad(q, pad_cfg(0, sp - S)).reshape(lead + (nb, blk, hd))
    def windows(t):
        tb = jnp.pad(t, pad_cfg(radius, sp - S + radius)).reshape(lead + (nb + 2, blk, hd))
        return jnp.concatenate([tb[..., i:i + nb, :, :] for i in range(3)], axis=-2)
    kw, vw = windows(k), windows(v)
    s = jnp.einsum('...bqd,...bkd->...bqk', qb, kw, preferred_element_type=jnp.float32)
    qi = jnp.arange(blk)[:, None]
    kj = jnp.arange(3 * blk)[None, :]
    rel = kj - radius - qi
    key_pos = jnp.arange(nb)[:, None, None] * blk + (kj - radius)[None]
    valid = (jnp.abs(rel) <= radius)[None] & (key_pos >= 0) & (key_pos < S)
    bias = bias_vec.astype(jnp.float32)[:, jnp.clip(rel + radius, 0, 2 * radius)][:, None]
    s = jnp.where(valid, s + bias, NEG_INF)
    m = jnp.max(s, axis=-1, keepdims=True)
    p = jnp.exp(s - m)
    den = jnp.sum(p, axis=-1, keepdims=True)
    o = jnp.einsum('...bqk,...bkd->...bqd', p, vw.astype(jnp.float32)) / den
    lse = (m + jnp.log(den))[..., 0]
    o = o.reshape(lead + (sp, hd))[..., :S, :]
    lse = lse.reshape(lead + (sp,))[..., :S]
    return o, lse


def dilated_group(q, k, v, bias_tab, window, dil):
    B, L, Hg, hd = q.shape
    S = L // dil
    radius = window // (2 * dil)
    def to_sub(t):
        return t.reshape(B, S, dil, Hg, hd).transpose(0, 2, 3, 1, 4)
    offs = jnp.arange(-radius, radius + 1) * dil
    bias_vec = bias_tab[t5_bucket(offs)].T
    o, lse = banded_attention(to_sub(q), to_sub(k), to_sub(v), bias_vec, radius)
    o = o.transpose(0, 3, 1, 2, 4).reshape(B, L, Hg, hd)
    lse = lse.transpose(0, 3, 1, 2).reshape(B, L, Hg)
    return o, lse


def dilated_attention(q, k, v, rel_bias, q_norm_g, k_norm_g):
    B, L, _ = q.shape
    q = rmsnorm(q.reshape(B, L, N_HEADS, HEAD_DIM), q_norm_g) * (HEAD_DIM ** -0.5)
    k = rmsnorm(k.reshape(B, L, N_HEADS, HEAD_DIM), k_norm_g)
    v = v.reshape(B, L, N_HEADS, HEAD_DIM)
    outs, lses = [], []
    for gi, (window, dil) in enumerate(DILATED_GROUPS):
        hs = slice(gi * HEADS_PER_GROUP, (gi + 1) * HEADS_PER_GROUP)
        o, lse = dilated_group(q[:, :, hs], k[:, :, hs], v[:, :, hs], rel_bias[:, hs], window, dil)
        outs.append(o)
        lses.append(lse)
    alpha = jax.nn.softmax(jnp.stack(lses), axis=0)
    o = jnp.sum(alpha[..., None] * jnp.stack(outs), axis=0)
    return o.reshape(B, L, ATTN_OUT_WIDTH).astype(q.dtype)


def short_conv(z, w, b):
    zp = jnp.pad(z, ((0, 0), (1, 1), (0, 0)))
    return zp[:, :-2] * w[0] + zp[:, 1:-1] * w[1] + zp[:, 2:] * w[2] + b


def implicit_filter(L, w1, b1, w2, b2, w3, b3, freq, w_out):
    f32 = jnp.float32
    t = jnp.linspace(0.0, 1.0, L, dtype=f32)[:, None]
    bands = jnp.linspace(1e-4, FILTER_BANDS - 1, FILTER_BANDS, dtype=f32)[None, :]
    w = 2.0 * math.pi * jnp.arange(L, dtype=f32)[:, None] / L
    feats = jnp.concatenate([t, jnp.cos(bands * w), -jnp.sin(bands * w)], axis=-1)
    fr = freq.astype(f32)
    h = jnp.sin(fr * (feats @ w1.astype(f32) + b1.astype(f32)))
    h = jnp.sin(fr * (h @ w2.astype(f32) + b2.astype(f32)))
    h = jnp.sin(fr * (h @ w3.astype(f32) + b3.astype(f32)))
    h = h @ w_out.astype(f32)
    deltas = jnp.abs(jnp.linspace(math.log(DECAY_TARGET) / SLOW_DECAY_PCT,
                                  math.log(DECAY_TARGET) / FAST_DECAY_PCT, D_HYENA, dtype=f32))
    decay = jnp.exp(-t * deltas[None, :])
    h_fwd, h_bwd = jnp.split(h, 2, axis=-1)
    h_fwd, h_bwd = h_fwd * decay, h_bwd * decay
    k2 = jnp.concatenate([h_fwd, jnp.zeros((1, D_HYENA), f32), h_bwd[1:][::-1]], axis=0)
    return k2 / jnp.sum(jnp.abs(k2), axis=0, keepdims=True)


def long_conv(u, k2, d):
    L = u.shape[1]
    uf = u.astype(jnp.float32)
    U = jnp.fft.rfft(uf, n=2 * L, axis=1)
    K = jnp.fft.rfft(k2, n=2 * L, axis=0)
    y = jnp.fft.irfft(U * K[None], n=2 * L, axis=1)[:, :L]
    return (y + uf * d.astype(jnp.float32)).astype(u.dtype)


def hyena_branch(z, conv_w, conv_b, w1, b1, w2, b2, w3, b3, freq, w_out, hyena_d):
    L = z.shape[1]
    zc = short_conv(z, conv_w, conv_b)
    x0, x1, v = jnp.split(zc, 3, axis=-1)
    k2 = implicit_filter(L, w1, b1, w2, b2, w3, b3, freq, w_out)
    return x0 * long_conv(x1 * v, k2, hyena_d)


def encoder_layer(x, c, rel_bias, ada_w, ada_b, norm1_g, w_in, conv_w, conv_b,
                  filt_w1, filt_b1, filt_w2, filt_b2, filt_w3, filt_b3, filt_freq, filt_w_out,
                  hyena_d, q_norm_g, k_norm_g, w_hy_br, w_at_br, w_out, norm2_g, w_up, w_down):
    mod = jax.nn.silu(c) @ ada_w + ada_b
    sh1, sc1, gt1, sh2, sc2, gt2 = jnp.split(mod[:, None, :], 6, axis=-1)
    u = rmsnorm(x, norm1_g) * (1.0 + sc1) + sh1
    z = u @ w_in
    o1 = 3 * D_HYENA
    z_hy, q, k, v, g = jnp.split(z, [o1, o1 + ATTN_WIDTH, o1 + 2 * ATTN_WIDTH, o1 + 3 * ATTN_WIDTH], axis=-1)
    y_hy = hyena_branch(z_hy, conv_w, conv_b, filt_w1, filt_b1, filt_w2, filt_b2,
                        filt_w3, filt_b3, filt_freq, filt_w_out, hyena_d)
    y_at = dilated_attention(q, k, v, rel_bias, q_norm_g, k_norm_g)
    g_hy, g_at = jnp.split(jax.nn.sigmoid(g), 2, axis=-1)
    mixed = (g_hy * (y_hy @ w_hy_br) + g_at * (y_at @ w_at_br)) @ w_out
    h = x + gt1 * mixed
    u2 = rmsnorm(h, norm2_g) * (1.0 + sc2) + sh2
    ff = jnp.square(jax.nn.relu(u2 @ w_up)) @ w_down
    return h + gt2 * ff


def setup_inputs(seed: int = 0) -> dict:
    key = jax.random.key(seed)
    ks = jax.random.split(key, 32)
    def nrm(k, shape, scale):
        return jax.random.normal(k, shape, jnp.float32) * scale
    return {
        'x_prompt': nrm(ks[0], (BATCH, SEQ, D_MODEL), 1.0),
        'x_sample': nrm(ks[1], (DEC_BATCH, DEC_SEQ, D_MODEL), 1.0),
        'c_prompt': nrm(ks[2], (BATCH, D_MODEL), 1.0),
        'c_sample': nrm(ks[3], (DEC_BATCH, D_MODEL), 1.0),
        'rel_bias': nrm(ks[4], (NUM_BUCKETS, N_HEADS), 0.5),
        'ada_w': nrm(ks[5], (DEPTH, D_MODEL, 6 * D_MODEL), D_MODEL ** -0.5),
        'ada_b': nrm(ks[6], (DEPTH, 6 * D_MODEL), 0.02),
        'norm1_g': 1.0 + nrm(ks[7], (DEPTH, D_MODEL), 0.02),
        'w_in': nrm(ks[8], (DEPTH, D_MODEL, IN_PROJ_WIDTH), D_MODEL ** -0.5),
        'conv_w': nrm(ks[9], (DEPTH, SHORT_CONV, 3 * D_HYENA), SHORT_CONV ** -0.5),
        'conv_b': nrm(ks[10], (DEPTH, 3 * D_HYENA), 0.02),
        'filt_w1': nrm(ks[11], (DEPTH, FILTER_EMB, FILTER_HIDDEN), FILTER_EMB ** -0.5),
        'filt_b1': nrm(ks[12], (DEPTH, FILTER_HIDDEN), 0.02),
        'filt_w2': nrm(ks[13], (DEPTH, FILTER_HIDDEN, FILTER_HIDDEN), FILTER_HIDDEN ** -0.5),
        'filt_b2': nrm(ks[14], (DEPTH, FILTER_HIDDEN), 0.02),
        'filt_w3': nrm(ks[15], (DEPTH, FILTER_HIDDEN, FILTER_HIDDEN), FILTER_HIDDEN ** -0.5),
        'filt_b3': nrm(ks[16], (DEPTH, FILTER_HIDDEN), 0.02),
        'filt_freq': 1.0 + nrm(ks[17], (DEPTH, FILTER_HIDDEN), 0.02),
        'filt_w_out': nrm(ks[18], (DEPTH, FILTER_HIDDEN, 2 * D_HYENA), FILTER_HIDDEN ** -0.5),
        'hyena_d': nrm(ks[19], (DEPTH, D_HYENA), 0.1),
        'q_norm_g': 1.0 + nrm(ks[20], (DEPTH, N_HEADS, HEAD_DIM), 0.02),
        'k_norm_g': 1.0 + nrm(ks[21], (DEPTH, N_HEADS, HEAD_DIM), 0.02),
        'w_hy_br': nrm(ks[22], (DEPTH, D_HYENA, D_MODEL), D_HYENA ** -0.5),
        'w_at_br': nrm(ks[23], (DEPTH, ATTN_OUT_WIDTH, D_MODEL), ATTN_OUT_WIDTH ** -0.5),
        'w_out': nrm(ks[24], (DEPTH, D_MODEL, D_MODEL), D_MODEL ** -0.5),
        'norm2_g': 1.0 + nrm(ks[25], (DEPTH, D_MODEL), 0.02),
        'w_up': nrm(ks[26], (DEPTH, D_MODEL, D_FF), D_MODEL ** -0.5),
        'w_down': nrm(ks[27], (DEPTH, D_FF, D_MODEL), D_FF ** -0.5),
    }


def reference(x_prompt, x_sample, c_prompt, c_sample, rel_bias, ada_w, ada_b, norm1_g, w_in,
              conv_w, conv_b, filt_w1, filt_b1, filt_w2, filt_b2, filt_w3, filt_b3, filt_freq,
              filt_w_out, hyena_d, q_norm_g, k_norm_g, w_hy_br, w_at_br, w_out, norm2_g, w_up, w_down):
    y_prompt, y_sample = x_prompt, x_sample
    for l in range(DEPTH):
        layer_params = (ada_w[l], ada_b[l], norm1_g[l], w_in[l], conv_w[l], conv_b[l],
                        filt_w1[l], filt_b1[l], filt_w2[l], filt_b2[l], filt_w3[l], filt_b3[l],
                        filt_freq[l], filt_w_out[l], hyena_d[l], q_norm_g[l], k_norm_g[l],
                        w_hy_br[l], w_at_br[l], w_out[l], norm2_g[l], w_up[l], w_down[l])
        y_prompt = encoder_layer(y_prompt, c_prompt, rel_bias, *layer_params)
        y_sample = encoder_layer(y_sample, c_sample, rel_bias, *layer_params)
    return (y_prompt, y_sample)
```

```cpp
#include <hip/hip_runtime.h>
#include <hip/hip_cooperative_groups.h>
#include <cstdio>
#include <cstdint>
namespace cg = cooperative_groups;

#ifndef MK_PER_PHASE
#define MK_PER_PHASE 0
#endif

namespace pg8 {
#define PG8_LAS __attribute__((address_space(3)))
typedef unsigned short bf16_t;
typedef short bf16x8 __attribute__((ext_vector_type(8)));
typedef float f32x4 __attribute__((ext_vector_type(4)));
typedef unsigned u32x4 __attribute__((ext_vector_type(4)));
constexpr int BM = 256, BK = 64, HALF = 128, HTB = HALF * BK * 2  , STAGE_BYTES = 8 * HTB, NXCD = 8, WGM = 8;

__host__ __device__ __forceinline__ int lds_byte(int r, int c) { const int st = (r >> 4) * 2 + (c >> 5), rr = r & 15, cc = c & 31, ob = rr * 64 + cc * 2; return st * 1024 + (ob ^ (((ob >> 9) & 1) << 5)); }
__host__ __device__ __forceinline__ void stage_rc(int b, int& R, int& C) { const int st = b / 1024, sb = b % 1024, swz = sb ^ (((sb >> 9) & 1) << 5); R = (st >> 1) * 16 + swz / 64; C = (st & 1) * 32 + (swz % 64) / 2; }
__host__ __device__ __forceinline__ int perm32(int rho) { const int n = rho >> 4, i = rho & 15; return 8 * (i >> 2) + 4 * n + (i & 3); }

struct Unit { int pm, pn; };
struct Gemm { const bf16_t* A; const bf16_t* Bt; int M, N, K; };

struct StaticOrder {
    int nM, nN, nwg, G, c;
    __host__ __device__ void init(int M, int N, int G_, int c_) { nM = M / BM; nN = N / BM; nwg = nM * nN; G = G_; c = c_; }
    __host__ __device__ bool next(int i, Unit& u) const {
        const long L = (long)i * G + c; if (L >= nwg) return false;
        int wgid = (int)L; { const int q = nwg / NXCD, r = nwg % NXCD, xcd = wgid % NXCD, off = wgid / NXCD; wgid = (xcd < r ? xcd * (q + 1) : r * (q + 1) + (xcd - r) * q) + off; }
        const int nig = WGM * nN, gid = wgid / nig, fm = gid * WGM, gsz = (nM - fm) < WGM ? (nM - fm) : WGM;
        u.pm = fm + ((wgid % nig) % gsz); u.pn = (wgid % nig) / gsz; return true;
    }
    __device__ __forceinline__ void a_ready(const Unit&) const {}
    __device__ __forceinline__ void done(const Unit&) const {}
};

typedef float f32x2_t __attribute__((ext_vector_type(2))); typedef __bf16 bf16x2_t __attribute__((ext_vector_type(2)));
__device__ __forceinline__ unsigned cvt_pk_bf16(float lo, float hi) { f32x2_t v = {lo, hi}; bf16x2_t b = __builtin_convertvector(v, bf16x2_t); return __builtin_bit_cast(unsigned, b); }
__device__ __forceinline__ float bf_lo(unsigned w) { return __uint_as_float(w << 16); }
__device__ __forceinline__ float bf_hi(unsigned w) { return __uint_as_float(w & 0xffff0000u); }
__device__ __forceinline__ float sigmoidf_(float x) { return __builtin_amdgcn_rcpf(1.0f + __expf(-x)); }

constexpr int E_MP = 65536;

template <int MODE> struct EpiB {
    static constexpr bool PERM = true, AFTER_DRAIN = false;
    bf16_t* O; int ldc; const bf16_t* G; bf16_t* O2; int zsplit; int gcol0 = 0;
    __device__ __forceinline__ void operator()(const f32x4 (&acc)[2][2][4][2], const Unit& u, int wr, int wc, int fr, int fq) const {
        const int row0 = u.pm * BM + wr * 64 + fr; int colt = u.pn * BM; bf16_t* base = O; int ld = ldc; bool sig = false;
        if (MODE == 1) { if (u.pn >= zsplit) { base = O2; ld = 2048; colt += gcol0 - zsplit * BM; sig = true; } }
        const int col0 = colt + wc * 32 + 8 * fq;
        constexpr int MB = (MODE == 3) ? 2 : 4;
#pragma unroll
        for (int ai = 0; ai < 2; ++ai)
#pragma unroll
            for (int mb = 0; mb < 4; mb += MB) {
                typedef unsigned u32x2g __attribute__((ext_vector_type(2)));
                u32x2g gq[MB][2]; u32x4 tq[MODE == 3 ? MB : 1][2];
                if (MODE == 2 || MODE == 3) {
#pragma unroll
                    for (int mm = 0; mm < MB; ++mm)
#pragma unroll
                        for (int bj = 0; bj < 2; ++bj) { const size_t row = (size_t)(row0 + ai * HALF + (mb + mm) * 16);
                            gq[mm][bj] = *(const u32x2g*)((const unsigned char*)G + row * 2048 + (MODE == 3 ? 1024 : 0) + col0 + bj * HALF);
                            if (MODE == 3) tq[mm][bj] = *(const u32x4*)(base + row * ld + col0 + bj * HALF); }
                }
#pragma unroll
                for (int mm = 0; mm < MB; ++mm) { const int m = mb + mm; const size_t row = (size_t)(row0 + ai * HALF + m * 16); bf16_t* rowp = base + row * ld + col0;
#pragma unroll
                    for (int bj = 0; bj < 2; ++bj) { f32x4 v0 = acc[ai][bj][m][0], v1 = acc[ai][bj][m][1];
                        if (MODE == 1) { if (sig) {
#pragma unroll
                            for (int j = 0; j < 4; ++j) { v0[j] = sigmoidf_(v0[j]); v1[j] = sigmoidf_(v1[j]); } } }
                        if (MODE == 2 || MODE == 3) {
                            const u32x2g g = gq[mm][bj]; const float k255 = 1.0f / 255.0f;
                            v0[0] *= (float)(g.x & 0xffu) * k255; v0[1] *= (float)((g.x >> 8) & 0xffu) * k255; v0[2] *= (float)((g.x >> 16) & 0xffu) * k255; v0[3] *= (float)(g.x >> 24) * k255;
                            v1[0] *= (float)(g.y & 0xffu) * k255; v1[1] *= (float)((g.y >> 8) & 0xffu) * k255; v1[2] *= (float)((g.y >> 16) & 0xffu) * k255; v1[3] *= (float)(g.y >> 24) * k255;
                            if (MODE == 3) { const u32x4 t = tq[mm][bj];
                                v0[0] += bf_lo(t.x); v0[1] += bf_hi(t.x); v0[2] += bf_lo(t.y); v0[3] += bf_hi(t.y);
                                v1[0] += bf_lo(t.z); v1[1] += bf_hi(t.z); v1[2] += bf_lo(t.w); v1[3] += bf_hi(t.w); }
                        }
                        if (MODE == 5) {
#pragma unroll
                            for (int j = 0; j < 4; ++j) { float a = fmaxf(v0[j], 0.f), b = fmaxf(v1[j], 0.f); v0[j] = a * a; v1[j] = b * b; } }
                        if (MODE == 1 && sig) {
                            typedef unsigned u32x2 __attribute__((ext_vector_type(2)));
                            unsigned lo = 0u, hv = 0u;
                            lo = __builtin_amdgcn_cvt_pk_u8_f32(v0[0] * 255.0f, 0, lo); lo = __builtin_amdgcn_cvt_pk_u8_f32(v0[1] * 255.0f, 1, lo); lo = __builtin_amdgcn_cvt_pk_u8_f32(v0[2] * 255.0f, 2, lo); lo = __builtin_amdgcn_cvt_pk_u8_f32(v0[3] * 255.0f, 3, lo);
                            hv = __builtin_amdgcn_cvt_pk_u8_f32(v1[0] * 255.0f, 0, hv); hv = __builtin_amdgcn_cvt_pk_u8_f32(v1[1] * 255.0f, 1, hv); hv = __builtin_amdgcn_cvt_pk_u8_f32(v1[2] * 255.0f, 2, hv); hv = __builtin_amdgcn_cvt_pk_u8_f32(v1[3] * 255.0f, 3, hv);
                            u32x2 w8; w8.x = lo; w8.y = hv;
                            *(u32x2*)((unsigned char*)O2 + row * 2048 + col0 + bj * HALF) = w8;
                        } else {
                        u32x4 w; w.x = cvt_pk_bf16(v0[0], v0[1]); w.y = cvt_pk_bf16(v0[2], v0[3]); w.z = cvt_pk_bf16(v1[0], v1[1]); w.w = cvt_pk_bf16(v1[2], v1[3]);
                        *(u32x4*)(rowp + bj * HALF) = w; } } }
                if (MODE == 2 || MODE == 3) asm volatile("" ::: "memory");
            }
    }
};
struct EpiH {
    static constexpr bool PERM = true, AFTER_DRAIN = false;
    const float* xp; const float* xs; bf16_t* H; const float* gate;
    __device__ __forceinline__ void operator()(const f32x4 (&acc)[2][2][4][2], const Unit& u, int wr, int wc, int fr, int fq) const {
        const int rowt = u.pm * BM; const int modrow = rowt < E_MP ? (rowt >> 13) : 8 + ((rowt - E_MP) >> 12);
        const float* gt = gate + (size_t)modrow * 6144;
        const float* src = rowt < E_MP ? xp : xs - (size_t)E_MP * 1024;
        const int row0 = rowt + wr * 64 + fr, col0 = u.pn * BM + wc * 32 + 8 * fq;
        f32x4 gv[2][2];
#pragma unroll
        for (int bj = 0; bj < 2; ++bj)
#pragma unroll
            for (int n = 0; n < 2; ++n) gv[bj][n] = *(const f32x4*)(gt + col0 + bj * HALF + 4 * n);
#pragma unroll
        for (int ai = 0; ai < 2; ++ai)
#pragma unroll
            for (int mb = 0; mb < 4; mb += 2) {
                f32x4 sq[2][2][2];
#pragma unroll
                for (int mm = 0; mm < 2; ++mm)
#pragma unroll
                    for (int bj = 0; bj < 2; ++bj)
#pragma unroll
                        for (int n = 0; n < 2; ++n) sq[mm][bj][n] = *(const f32x4*)(src + (size_t)(row0 + ai * HALF + (mb + mm) * 16) * 1024 + col0 + bj * HALF + 4 * n);
#pragma unroll
                for (int mm = 0; mm < 2; ++mm)
#pragma unroll
                    for (int bj = 0; bj < 2; ++bj) { const f32x4 v0 = sq[mm][bj][0] + gv[bj][0] * acc[ai][bj][mb + mm][0], v1 = sq[mm][bj][1] + gv[bj][1] * acc[ai][bj][mb + mm][1];
                        u32x4 w; w.x = cvt_pk_bf16(v0[0], v0[1]); w.y = cvt_pk_bf16(v0[2], v0[3]); w.z = cvt_pk_bf16(v1[0], v1[1]); w.w = cvt_pk_bf16(v1[2], v1[3]);
                        *(u32x4*)(H + (size_t)(row0 + ai * HALF + (mb + mm) * 16) * 1024 + col0 + bj * HALF) = w; }
                asm volatile("" ::: "memory");
            }
    }
};
struct EpiF {
    static constexpr bool PERM = false, AFTER_DRAIN = false;
    const bf16_t* H; float* out; const float* gate; int row_off;
    __device__ __forceinline__ void operator()(const f32x4 (&acc)[2][2][4][2], const Unit& u, int wr, int wc, int fr, int fq) const {
        typedef unsigned u32x2 __attribute__((ext_vector_type(2)));
        const int rowt = row_off + u.pm * BM; const int modrow = rowt < E_MP ? (rowt >> 13) : 8 + ((rowt - E_MP) >> 12);
        const float* gt = gate + (size_t)modrow * 6144;
        const int row0 = rowt + wr * 64 + fr, col0 = u.pn * BM + wc * 32 + 4 * fq;
        f32x4 gv[2][2];
#pragma unroll
        for (int bj = 0; bj < 2; ++bj)
#pragma unroll
            for (int n = 0; n < 2; ++n) gv[bj][n] = *(const f32x4*)(gt + col0 + bj * HALF + n * 16);
#pragma unroll
        for (int ai = 0; ai < 2; ++ai) {
            u32x2 hq[4][2][2];
#pragma unroll
            for (int m = 0; m < 4; ++m)
#pragma unroll
                for (int bj = 0; bj < 2; ++bj)
#pragma unroll
                    for (int n = 0; n < 2; ++n) hq[m][bj][n] = *(const u32x2*)(H + (size_t)(row0 + ai * HALF + m * 16) * 1024 + col0 + bj * HALF + n * 16);
#pragma unroll
            for (int m = 0; m < 4; ++m)
#pragma unroll
                for (int bj = 0; bj < 2; ++bj)
#pragma unroll
                    for (int n = 0; n < 2; ++n) { const u32x2 h = hq[m][bj][n]; f32x4 hv; hv[0] = bf_lo(h.x); hv[1] = bf_hi(h.x); hv[2] = bf_lo(h.y); hv[3] = bf_hi(h.y);
                        *(f32x4*)(out + (size_t)(row0 + ai * HALF + m * 16) * 1024 + col0 + bj * HALF + n * 16) = hv + gv[bj][n] * acc[ai][bj][m][n]; }
            asm volatile("" ::: "memory");
        }
    }
};

template <class Epi, class Sched, bool ALIGN_EPI = false, bool SP2 = false>
__device__ __forceinline__ void gemm_phase(PG8_LAS unsigned char* lds, const Gemm g, const Sched& S, const Epi& E) {
    const int tid = threadIdx.x, wid = __builtin_amdgcn_readfirstlane(tid >> 6), lane = tid & 63, wr = wid >> 2, wc = wid & 3, fr = lane & 15, fq = lane >> 4;
    const int K = g.K, nt = K / BK;
    unsigned voffA[2], voffB[2];
#pragma unroll
    for (int i = 0; i < 2; ++i) { int R, C; stage_rc(tid * 16 + i * 8192, R, C); const int Rb = Epi::PERM ? ((R & ~31) + perm32(R & 31)) : R;
        voffA[i] = (unsigned)(R * K + C) * 2u; voffB[i] = (unsigned)(Rb * K + C) * 2u; }
    const size_t kstep = (size_t)(BK * 2);
    const size_t hstep = (size_t)HALF * K * 2;
    const size_t tstep = 2 * hstep;
    const unsigned ldsw = (unsigned)wid * 1024u;
    const int aoff = lds_byte(wr * 64 + fr, fq * 8), boff = lds_byte(wc * 32 + fr, fq * 8);
#define PG8_SA(b, h) (((b) * 2 + (h)) * HTB)
#define PG8_SB(b, h) ((4 + (b) * 2 + (h)) * HTB)
#define PG8_STAGE(bufoff, gbase, voff) do { _Pragma("unroll") for (int _i = 0; _i < 2; ++_i) \
        __builtin_amdgcn_global_load_lds((const unsigned*)((const char*)(gbase) + (voff)[_i]), (PG8_LAS unsigned*)(lds + (bufoff) + ldsw + _i * 8192), 16, 0, 0); } while (0)
#define PG8_LDA(dst, b, h) do { _Pragma("unroll") for (int m = 0; m < 4; ++m) _Pragma("unroll") for (int k = 0; k < 2; ++k) dst[m][k] = *(const PG8_LAS bf16x8*)(lds + PG8_SA(b, h) + aoff + m * 2048 + k * 1024); } while (0)
#define PG8_LDB(dst, b, h) do { _Pragma("unroll") for (int n = 0; n < 2; ++n) _Pragma("unroll") for (int k = 0; k < 2; ++k) dst[n][k] = *(const PG8_LAS bf16x8*)(lds + PG8_SB(b, h) + boff + n * 2048 + k * 1024); } while (0)
#define PG8_MMA(ai, bj, At, Bt) do { __builtin_amdgcn_s_setprio(1); _Pragma("unroll") for (int m = 0; m < 4; ++m) _Pragma("unroll") for (int n = 0; n < 2; ++n) _Pragma("unroll") for (int k = 0; k < 2; ++k) \
        acc[ai][bj][m][n] = __builtin_amdgcn_mfma_f32_16x16x32_bf16(Bt[n][k], At[m][k], acc[ai][bj][m][n], 0, 0, 0); __builtin_amdgcn_s_setprio(0); } while (0)
#define PG8_WAIT_V(n) asm volatile("s_waitcnt vmcnt(" #n ")" ::: "memory")
#define PG8_WAIT_L(n) asm volatile("s_waitcnt lgkmcnt(" #n ")" ::: "memory")
#define PG8_BAR __builtin_amdgcn_s_barrier()
#define PG8_SCHED __builtin_amdgcn_sched_barrier(0)
    Unit cur, nxt; int ui = 0;
    if (!S.next(0, cur)) return;
    f32x4 acc[2][2][4][2];
#pragma unroll
    for (int a = 0; a < 2; ++a)
#pragma unroll
        for (int b = 0; b < 2; ++b)
#pragma unroll
            for (int m = 0; m < 4; ++m)
#pragma unroll
                for (int n = 0; n < 2; ++n) acc[a][b][m][n] = (f32x4){0.f, 0.f, 0.f, 0.f};
    bf16x8 At[4][2], B0[2][2], B1[2][2];
    const char* cA = (const char*)g.A + (size_t)cur.pm * tstep; const char* cB = (const char*)g.Bt + (size_t)cur.pn * tstep;
    S.a_ready(cur);
    if constexpr (SP2) {
        PG8_STAGE(PG8_SB(0, 0), cB, voffB); PG8_STAGE(PG8_SB(0, 1), cB + hstep, voffB); PG8_STAGE(PG8_SA(0, 0), cA, voffA); PG8_STAGE(PG8_SA(0, 1), cA + hstep, voffA);
        if (wr == 1) PG8_BAR;
        PG8_WAIT_V(2); PG8_BAR;
        PG8_STAGE(PG8_SB(1, 0), cB + kstep, voffB); PG8_STAGE(PG8_SA(1, 0), cA + kstep, voffA); PG8_STAGE(PG8_SB(1, 1), cB + hstep + kstep, voffB);
        PG8_WAIT_V(6); PG8_BAR;
    } else {
        PG8_STAGE(PG8_SB(0, 0), cB, voffB); PG8_STAGE(PG8_SA(0, 0), cA, voffA); PG8_STAGE(PG8_SB(0, 1), cB + hstep, voffB); PG8_STAGE(PG8_SA(0, 1), cA + hstep, voffA);
        if (wr == 1) PG8_BAR;
        PG8_WAIT_V(4); PG8_BAR;
        PG8_STAGE(PG8_SB(1, 0), cB + kstep, voffB); PG8_STAGE(PG8_SA(1, 0), cA + kstep, voffA); PG8_STAGE(PG8_SB(1, 1), cB + hstep + kstep, voffB);
        PG8_WAIT_V(6); PG8_BAR;
    }
    for (;;) {
        const bool has_next = S.next(ui + 1, nxt);
        const char* nA = has_next ? (const char*)g.A + (size_t)nxt.pm * tstep : cA; const char* nB = has_next ? (const char*)g.Bt + (size_t)nxt.pn * tstep : cB;
        for (int t = 0; t < nt; t += 2) {
            const bool last = (t == nt - 2);
            const char* a1 = cA + (size_t)(t + 1) * kstep;
            const char* a2 = last ? nA : cA + (size_t)(t + 2) * kstep; const char* b2 = last ? nB : cB + (size_t)(t + 2) * kstep;
            const char* a3 = a2 + kstep; const char* b3 = b2 + kstep;
            if (last && has_next) S.a_ready(nxt);
            if constexpr (SP2) {
            PG8_LDB(B0, 0, 0); PG8_LDB(B1, 0, 1); PG8_SCHED; PG8_LDA(At, 0, 0); PG8_STAGE(PG8_SA(1, 1), a1 + hstep, voffA);
            PG8_WAIT_V(8); PG8_WAIT_L(0); PG8_BAR; PG8_MMA(0, 0, At, B0); PG8_MMA(0, 1, At, B1); PG8_BAR; PG8_SCHED;
            PG8_LDA(At, 0, 1); PG8_STAGE(PG8_SB(0, 0), b2, voffB); PG8_STAGE(PG8_SB(0, 1), b2 + hstep, voffB); PG8_STAGE(PG8_SA(0, 0), a2, voffA);
            PG8_WAIT_V(8); PG8_WAIT_L(0); PG8_BAR; PG8_MMA(1, 0, At, B0); PG8_MMA(1, 1, At, B1); PG8_BAR; PG8_SCHED;
            PG8_LDB(B0, 1, 0); PG8_LDB(B1, 1, 1); PG8_SCHED; PG8_LDA(At, 1, 0); PG8_STAGE(PG8_SA(0, 1), a2 + hstep, voffA);
            PG8_WAIT_V(8); PG8_WAIT_L(0); PG8_BAR; PG8_MMA(0, 0, At, B0); PG8_MMA(0, 1, At, B1); PG8_BAR; PG8_SCHED;
            PG8_LDA(At, 1, 1); PG8_STAGE(PG8_SB(1, 0), b3, voffB); PG8_STAGE(PG8_SB(1, 1), b3 + hstep, voffB); PG8_STAGE(PG8_SA(1, 0), a3, voffA);
            PG8_WAIT_V(8); PG8_WAIT_L(0); PG8_BAR; PG8_MMA(1, 0, At, B0); PG8_MMA(1, 1, At, B1); PG8_BAR; PG8_SCHED;
            } else {
            PG8_LDB(B0, 0, 0); PG8_SCHED; PG8_LDA(At, 0, 0); PG8_STAGE(PG8_SA(1, 1), a1 + hstep, voffA);
            PG8_WAIT_L(8); PG8_BAR; PG8_WAIT_L(0); PG8_MMA(0, 0, At, B0); PG8_BAR; PG8_SCHED;
            PG8_LDB(B1, 0, 1); PG8_STAGE(PG8_SB(0, 0), b2, voffB);
            PG8_BAR; PG8_WAIT_L(0); PG8_MMA(0, 1, At, B1); PG8_BAR;
            PG8_LDA(At, 0, 1); PG8_STAGE(PG8_SA(0, 0), a2, voffA);
            PG8_BAR; PG8_WAIT_L(0); PG8_MMA(1, 0, At, B0); PG8_BAR; PG8_SCHED;
            PG8_STAGE(PG8_SB(0, 1), b2 + hstep, voffB);
            PG8_WAIT_V(6); PG8_BAR; PG8_MMA(1, 1, At, B1); PG8_BAR;
            PG8_LDB(B0, 1, 0); PG8_SCHED; PG8_LDA(At, 1, 0); PG8_STAGE(PG8_SA(0, 1), a2 + hstep, voffA);
            PG8_WAIT_L(8); PG8_BAR; PG8_WAIT_L(0); PG8_MMA(0, 0, At, B0); PG8_BAR; PG8_SCHED;
            PG8_LDB(B1, 1, 1); PG8_STAGE(PG8_SB(1, 0), b3, voffB);
            PG8_BAR; PG8_WAIT_L(0); PG8_MMA(0, 1, At, B1); PG8_BAR;
            PG8_LDA(At, 1, 1); PG8_STAGE(PG8_SA(1, 0), a3, voffA);
            PG8_BAR; PG8_WAIT_L(0); PG8_MMA(1, 0, At, B0); PG8_BAR; PG8_SCHED;
            PG8_STAGE(PG8_SB(1, 1), b3 + hstep, voffB);
            PG8_WAIT_V(6); PG8_BAR; PG8_MMA(1, 1, At, B1); PG8_BAR;
            }
        }
        if constexpr (ALIGN_EPI) { if (wr == 0) PG8_BAR; }
        if constexpr (!Epi::AFTER_DRAIN) { E(acc, cur, wr, wc, fr, fq); S.done(cur); }
        if (!has_next) break;
#pragma unroll
        for (int a = 0; a < 2; ++a)
#pragma unroll
            for (int b = 0; b < 2; ++b)
#pragma unroll
                for (int m = 0; m < 4; ++m)
#pragma unroll
                    for (int n = 0; n < 2; ++n) acc[a][b][m][n] = (f32x4){0.f, 0.f, 0.f, 0.f};
        cur = nxt; cA = nA; cB = nB; ++ui;
        if constexpr (ALIGN_EPI) { if (wr == 1) PG8_BAR; }
    }
    PG8_WAIT_V(0);
    if constexpr (!ALIGN_EPI) { if (wr == 0) PG8_BAR; }
    PG8_BAR;
    if constexpr (Epi::AFTER_DRAIN) { E.fused(acc, cur, wr, wc, fr, fq, lds, wid, lane); S.done(cur); }
#undef PG8_SA
#undef PG8_SB
#undef PG8_STAGE
#undef PG8_LDA
#undef PG8_LDB
#undef PG8_MMA
#undef PG8_WAIT_V
#undef PG8_WAIT_L
#undef PG8_BAR
#undef PG8_SCHED
}
}

constexpr int DM = 1024, LP = 8192, LS = 4096, NB = 8;
constexpr int MP = NB * LP, MS = NB * LS, MT = MP + MS;
constexpr int DH = 768, ZW = 2304, QW = 2304, GW = 2048, DFF = 4096, NIN = 6656;
constexpr float RMS_EPS = 1e-6f;
static_assert(MP == pg8::E_MP, "row split");
constexpr size_t MiB = 1u << 20;
constexpr size_t WS_MOD = 0, WS_H3 = 1 * MiB, WS_BAR = 4 * MiB;
constexpr size_t WS_WIN = 8 * MiB, WS_WHB = 21 * MiB, WS_WAB = 23 * MiB, WS_WOUT = 24 * MiB, WS_WUP = 26 * MiB, WS_WDN = 34 * MiB;
constexpr size_t WS_U1 = 48 * MiB, WS_KSPEC = 48 * MiB, WS_T1 = 48 * MiB;
constexpr size_t WS_H16 = 240 * MiB, WS_FF = 432 * MiB;
constexpr size_t WS_QKV = 240 * MiB, WS_ZHY = 240 * MiB;
constexpr size_t WS_OG = 672 * MiB, WS_UCT = 672 * MiB;
constexpr size_t WS_LSE = 816 * MiB, WS_YH = 816 * MiB, WS_U2 = 816 * MiB;
constexpr size_t WS_YAT = 960 * MiB, WS_END = 1008 * MiB;
constexpr size_t WS_KRAW = 880 * MiB;
constexpr int LDS_BYTES = 147456;
constexpr int NPHASE = 16;

#define LAS __attribute__((address_space(3)))
typedef unsigned short bf16;
typedef unsigned v4u __attribute__((ext_vector_type(4)));
typedef unsigned v2u __attribute__((ext_vector_type(2)));
typedef float f32x4 __attribute__((ext_vector_type(4)));
typedef short bf16x8 __attribute__((ext_vector_type(8)));
typedef float f32x16 __attribute__((ext_vector_type(16)));
#define LDS_WAIT() asm volatile("s_waitcnt lgkmcnt(0)" ::: "memory")
__device__ __forceinline__ float bf2f(unsigned short h) { return __uint_as_float((unsigned)h << 16); }
__device__ __forceinline__ unsigned pk2(float lo, float hi) { return pg8::cvt_pk_bf16(lo, hi); }
__device__ __forceinline__ float wave_sum(float v) {
#pragma unroll
    for (int o = 1; o < 64; o <<= 1) v += __shfl_xor(v, o);
    return v;
}

#define FFT_DI __device__ __forceinline__
#define FFT_ASM 1
#define FFT_SINCOSPI(x, s, c) do { const float h_ = 0.5f * (x); (s) = __builtin_amdgcn_sinf(h_); (c) = __builtin_amdgcn_cosf(h_); } while (0)
__device__ __forceinline__ int lnd(int x) { asm volatile("" : "+v"(x)); return x; }
#define FFT_LND(x) lnd(x)
#define FFT_SCHED() __builtin_amdgcn_sched_barrier(0)
#ifndef GEMM_SP2
#define GEMM_SP2 true
#endif
#define FFT_TRANS_FENCE(a, b) asm volatile("s_nop 1" : "+v"(a), "+v"(b))
#ifndef GEMM_ALIGN
#define GEMM_ALIGN true
#endif
typedef float cf2 __attribute__((ext_vector_type(2)));
#ifdef FFT_ASM
FFT_DI cf2 cmul_conjw(cf2 d, cf2 W) { cf2 t, o; asm("v_pk_mul_f32 %0, %1, %2 op_sel_hi:[1,0]" : "=v"(t) : "v"(d), "v"(W));
    asm("v_pk_fma_f32 %0, %1, %2, %3 op_sel:[1,1,0] op_sel_hi:[0,1,1] neg_hi:[1,0,0]" : "=v"(o) : "v"(d), "v"(W), "v"(t)); return o; }
FFT_DI cf2 cmul_w(cf2 b, cf2 W) { cf2 t, o; asm("v_pk_mul_f32 %0, %1, %2 op_sel_hi:[1,0]" : "=v"(t) : "v"(b), "v"(W));
    asm("v_pk_fma_f32 %0, %1, %2, %3 op_sel:[1,1,0] op_sel_hi:[0,1,1] neg_lo:[1,0,0]" : "=v"(o) : "v"(b), "v"(W), "v"(t)); return o; }
#else
FFT_DI cf2 cmul_conjw(cf2 d, cf2 W) { cf2 dr; dr.x = d.y; dr.y = -d.x; return d * __builtin_shufflevector(W, W, 0, 0) + dr * __builtin_shufflevector(W, W, 1, 1); }
FFT_DI cf2 cmul_w(cf2 b, cf2 W) { cf2 br; br.x = -b.y; br.y = b.x; return b * __builtin_shufflevector(W, W, 0, 0) + br * __builtin_shufflevector(W, W, 1, 1); }
#endif
FFT_DI cf2 cmul(cf2 a, cf2 b) { return cmul_w(a, b); }
#define FFT_C32(j) ((j) == 0 ? 1.0f : (j) == 1 ? 0.98078528040323043f : (j) == 2 ? 0.92387953251128674f : (j) == 3 ? 0.83146961230254524f : (j) == 4 ? 0.70710678118654752f : (j) == 5 ? 0.55557023301960218f : (j) == 6 ? 0.38268343236508977f : (j) == 7 ? 0.19509032201612825f : (j) == 8 ? 0.0f : (j) == 9 ? -0.19509032201612825f : (j) == 10 ? -0.38268343236508977f : (j) == 11 ? -0.55557023301960218f : (j) == 12 ? -0.70710678118654752f : (j) == 13 ? -0.83146961230254524f : (j) == 14 ? -0.92387953251128674f : -0.98078528040323043f)
FFT_DI constexpr float fft_cos32(int j) { return FFT_C32(j); }
FFT_DI constexpr float fft_sin32(int j) { return FFT_C32((j) >= 8 ? (j) - 8 : 8 - (j)); }

template <int Q, bool Z>
FFT_DI void fft_twiddles(cf2 (&Wm)[16], int i0low, int slog) {
    constexpr int q = Q;
    if (Z) {
#pragma unroll
        for (int m = 0; m < (1 << q); ++m) { Wm[m].x = fft_cos32(m << (4 - q)); Wm[m].y = fft_sin32(m << (4 - q)); }
    } else {
        float sb, cb; FFT_SINCOSPI((float)FFT_LND(i0low) * (1.0f / (float)(1 << (slog + q))), sb, cb);
        FFT_TRANS_FENCE(sb, cb);
        Wm[0].x = cb; Wm[0].y = sb;
        cf2 R; R.x = fft_cos32(1 << (4 - q)); R.y = fft_sin32(1 << (4 - q));
#pragma unroll
        for (int m = 1; m < (1 << q); ++m) Wm[m] = cmul_w(Wm[m - 1], R);
    }
}
template <int K, int OFF, int Q, bool Z>
FFT_DI void dif_stage(cf2 (&v)[32], int i0low, int slog) {
    constexpr int q = Q;
    cf2 Wm[16]; fft_twiddles<Q, Z>(Wm, i0low, slog);
#pragma unroll
    for (int e = 0; e < (1 << K); ++e) if (!(e & (1 << q))) {
        const int m = e & ((1 << q) - 1);
        const cf2 a = v[OFF + e], b = v[OFF + e + (1 << q)];
        v[OFF + e] = a + b;
        const cf2 d = a - b;
        if (Z && m == 0) v[OFF + e + (1 << q)] = d; else v[OFF + e + (1 << q)] = cmul_conjw(d, Wm[m]);
    }
}
template <int K, int OFF, bool Z = false>
FFT_DI void dif_stages(cf2 (&v)[32], int i0low, int slog) {
    if constexpr (K >= 5) dif_stage<K, OFF, 4, Z>(v, i0low, slog);
    dif_stage<K, OFF, 3, Z>(v, i0low, slog); dif_stage<K, OFF, 2, Z>(v, i0low, slog); dif_stage<K, OFF, 1, Z>(v, i0low, slog); dif_stage<K, OFF, 0, Z>(v, i0low, slog);
}
template <int K, int OFF, int Q, bool Z>
FFT_DI void dit_stage(cf2 (&v)[32], int i0low, int slog) {
    constexpr int q = Q;
    cf2 Wm[16]; fft_twiddles<Q, Z>(Wm, i0low, slog);
#pragma unroll
    for (int e = 0; e < (1 << K); ++e) if (!(e & (1 << q))) {
        const int m = e & ((1 << q) - 1);
        const cf2 a = v[OFF + e], b0 = v[OFF + e + (1 << q)];
        cf2 bw; if (Z && m == 0) bw = b0; else bw = cmul_w(b0, Wm[m]);
        v[OFF + e] = a + bw; v[OFF + e + (1 << q)] = a - bw;
    }
}
template <int K, int OFF, bool Z = false>
FFT_DI void dit_stages(cf2 (&v)[32], int i0low, int slog) {
    dit_stage<K, OFF, 0, Z>(v, i0low, slog); dit_stage<K, OFF, 1, Z>(v, i0low, slog); dit_stage<K, OFF, 2, Z>(v, i0low, slog); dit_stage<K, OFF, 3, Z>(v, i0low, slog);
    if constexpr (K >= 5) dit_stage<K, OFF, 4, Z>(v, i0low, slog);
}
FFT_DI int fft_swz(int i) { return i ^ ((i >> 5) & 31); }
FFT_DI int fft_idxA(int tid, int e) { return tid + 512 * e; }
FFT_DI int fft_idxB(int tid, int e) { return ((tid >> 4) << 9) + (tid & 15) + 16 * e; }
FFT_DI int fft_idxC(int tid, int e) { return 32 * tid + e; }

struct Args { const float* in[28]; float* out; unsigned char* ws; int ph_lo, ph_hi; };
enum { I_XP = 0, I_XS, I_CP, I_CS, I_RELB, I_ADAW, I_ADAB, I_N1G, I_WIN, I_CONVW, I_CONVB, I_FW1, I_FB1, I_FW2, I_FB2, I_FW3, I_FB3, I_FFREQ, I_FWOUT,
       I_HYD, I_QNG, I_KNG, I_WHB, I_WAB, I_WOUT, I_N2G, I_WUP, I_WDN };

__device__ __forceinline__ void p0_transpose_item(const float* W, int K, int N, bf16* WT, int row_off, LAS float* scr, int item, int lane) {
    const int nblk = N / 32, kb = item / nblk, nb = item % nblk, k0 = 64 * kb, n0 = 32 * nb;
#pragma unroll 8
    for (int i = 0; i < 32; ++i) { const int kk = 2 * i + (lane >> 5); scr[kk * 33 + (lane & 31)] = W[(size_t)(k0 + kk) * N + n0 + (lane & 31)]; }
    LDS_WAIT();
    const int c = lane & 7;
#pragma unroll
    for (int j = 0; j < 4; ++j) { const int n = (lane >> 3) + 8 * j; const LAS float* s = scr + (8 * c) * 33 + n;
        v4u o; o.x = pk2(s[0 * 33], s[1 * 33]); o.y = pk2(s[2 * 33], s[3 * 33]); o.z = pk2(s[4 * 33], s[5 * 33]); o.w = pk2(s[6 * 33], s[7 * 33]);
        *(v4u*)(WT + (size_t)(row_off + n0 + n) * K + k0 + 8 * c) = o; }
    LDS_WAIT();
}

__device__ __forceinline__ void p0_mod(const Args& a, LAS unsigned char* lds, int bid, int G, int tid) {
    LAS float* S = (LAS float*)lds;
    LAS float* P = (LAS float*)(lds + 65536);
    const int wave = tid >> 6, lane = tid & 63;
    float* MOD = (float*)(a.ws + WS_MOD);
    for (int cb = bid; cb < 96; cb += G) {
        for (int idx = tid; idx < 16384; idx += 512) { const int r = idx >> 10, k = idx & 1023;
            const float c = r < 8 ? a.in[I_CP][r * 1024 + k] : a.in[I_CS][(r - 8) * 1024 + k];
            S[k * 16 + r] = c / (1.0f + __expf(-c)); }
        __syncthreads();
        float acc[16];
#pragma unroll
        for (int r = 0; r < 16; ++r) acc[r] = 0.f;
        const float* wp = a.in[I_ADAW] + cb * 64 + lane;
#pragma unroll 4
        for (int k = wave * 128; k < wave * 128 + 128; ++k) {
            const float wv = wp[(size_t)k * 6144];
#pragma unroll
            for (int r4 = 0; r4 < 4; ++r4) { const f32x4 s = *(const LAS f32x4*)(S + k * 16 + r4 * 4);
                acc[r4 * 4 + 0] += s.x * wv; acc[r4 * 4 + 1] += s.y * wv; acc[r4 * 4 + 2] += s.z * wv; acc[r4 * 4 + 3] += s.w * wv; }
        }
#pragma unroll
        for (int r = 0; r < 16; ++r) P[(wave * 16 + r) * 64 + lane] = acc[r];
        __syncthreads();
        for (int o = tid; o < 1024; o += 512) { const int r = o >> 6, col = o & 63; float s = a.in[I_ADAB][cb * 64 + col];
#pragma unroll
            for (int w = 0; w < 8; ++w) s += P[(w * 16 + r) * 64 + col];
            MOD[r * 6144 + cb * 64 + col] = s; }
        __syncthreads();
    }
}

__device__ __forceinline__ void p0_h3(const Args& a, int gw, int NGW, int lane) {
    float* H3 = (float*)(a.ws + WS_H3);
    const float fr = a.in[I_FFREQ][lane];
    const float b1 = a.in[I_FB1][lane], b2 = a.in[I_FB2][lane], b3 = a.in[I_FB3][lane];
    for (int p = gw; p < LP + LS; p += NGW) {
        const int grp = p >= LP, t = p - grp * LP, L = grp ? LS : LP;
        const float tt = (float)t * (1.0f / (float)(L - 1));
        const float w = 6.2831853071795864769f * (float)t / (float)L;
        float feat = 0.f;
        if (lane == 0) feat = tt;
        else if (lane <= 32) { const int bi = (lane - 1) & 15; const float band = 1e-4f + (float)bi * ((15.0f - 1e-4f) / 15.0f); const float ang = band * w;
            feat = lane <= 16 ? cosf(ang) : -sinf(ang); }
        float acc = b1;
        for (int i = 0; i < 33; ++i) acc += __shfl(feat, i) * a.in[I_FW1][i * 64 + lane];
        float h = sinf(fr * acc);
        acc = b2;
        for (int i = 0; i < 64; ++i) acc += __shfl(h, i) * a.in[I_FW2][i * 64 + lane];
        h = sinf(fr * acc);
        acc = b3;
        for (int i = 0; i < 64; ++i) acc += __shfl(h, i) * a.in[I_FW3][i * 64 + lane];
        h = sinf(fr * acc);
        H3[(size_t)p * 64 + lane] = h;
    }
}

__device__ __forceinline__ void kraw_sub(const float* wout, float* KR, const float (&h)[64], int p, int c0, int cb, float tt, int lane) {
    const float* wr = wout + lane * 1536 + c0 + 12 * cb;
    const f32x4 w0 = *(const f32x4*)(wr), w1 = *(const f32x4*)(wr + 4), w2 = *(const f32x4*)(wr + 8);
    float wv[12] = {w0.x, w0.y, w0.z, w0.w, w1.x, w1.y, w1.z, w1.w, w2.x, w2.y, w2.z, w2.w};
#pragma unroll
    for (int ci = 0; ci < 12; ++ci) { const int c = c0 + 12 * cb + ci;
        float acc = 0.f;
#pragma unroll
        for (int jj = 0; jj < 64; ++jj) acc += h[jj] * __builtin_bit_cast(float, __builtin_amdgcn_readlane(__builtin_bit_cast(int, wv[ci]), jj));
        const int cm = c % 768;
        const float delta = fabsf(-3.0701134573253945f + (float)cm * ((-15.350567286626973f + 3.0701134573253945f) / 767.0f));
        KR[(size_t)c * (LP + LS) + p] = acc * __expf(-tt * delta); }
}
template <bool BF, bool KRAW> __device__ __forceinline__ void prep_rows(const float* xp, const float* xs, const bf16* hb, const float* g, const float* MOD, int shoff, int scoff, bf16* U, int gw, int NGW, int lane,
                                                                      const float* wout = nullptr, const float* H3 = nullptr, float* KR = nullptr) {
    constexpr int R = 4;
    float h[64]; int kit = gw, kcb = 0, kp = 0, kc0 = 0; float ktt = 0.f; bool kval = KRAW && kit < 192 * 32;
#define KRAW_STEP() do { if (kcb == 0) { kp = (kit >> 5) * 64 + lane; kc0 = (kit & 31) * 48; \
            _Pragma("unroll") for (int q = 0; q < 16; ++q) { const f32x4 t = *(const f32x4*)(H3 + (size_t)kp * 64 + 4 * q); h[4 * q] = t.x; h[4 * q + 1] = t.y; h[4 * q + 2] = t.z; h[4 * q + 3] = t.w; } \
            const int grp = kp >= LP, tpos = kp - grp * LP, L = grp ? LS : LP; ktt = (float)tpos * (1.0f / (float)(L - 1)); } \
        kraw_sub(wout, KR, h, kp, kc0, kcb, ktt, lane); if (++kcb == 4) { kcb = 0; kit += NGW; kval = kit < 192 * 32; } } while (0)
    for (int mb = gw; mb < MT; mb += R * NGW) {
        f32x4 v[R][4]; float s[R];
#pragma unroll
        for (int r = 0; r < R; ++r) { const int m = mb + r * NGW; const int mc = m < MT ? m : mb;
#pragma unroll
            for (int j = 0; j < 4; ++j) {
                if (BF) { const v2u a0 = *(const v2u*)(hb + (size_t)mc * DM + 4 * lane + 256 * j);
                    v[r][j].x = pg8::bf_lo(a0.x); v[r][j].y = pg8::bf_hi(a0.x); v[r][j].z = pg8::bf_lo(a0.y); v[r][j].w = pg8::bf_hi(a0.y); }
                else { const float* xr = mc < MP ? xp + (size_t)mc * DM : xs + (size_t)(mc - MP) * DM; v[r][j] = *(const f32x4*)(xr + 4 * lane + 256 * j); } } }
        if (KRAW) { if (kval) KRAW_STEP(); }
#pragma unroll
        for (int r = 0; r < R; ++r) { float t = 0.f;
#pragma unroll
            for (int j = 0; j < 4; ++j) t += (v[r][j].x * v[r][j].x + v[r][j].y * v[r][j].y) + (v[r][j].z * v[r][j].z + v[r][j].w * v[r][j].w);
            s[r] = t; }
#pragma unroll
        for (int o = 1; o < 64; o <<= 1) {
#pragma unroll
            for (int r = 0; r < R; ++r) s[r] += __shfl_xor(s[r], o); }
#pragma unroll
        for (int r = 0; r < R; ++r) { const int m = mb + r * NGW; if (m < MT) {
            const float rstd = 1.0f / sqrtf(s[r] * (1.0f / DM) + RMS_EPS);
            const float* mr = MOD + (size_t)(m < MP ? (m >> 13) : 8 + ((m - MP) >> 12)) * 6144;
#pragma unroll
            for (int j = 0; j < 4; ++j) { const int c = 4 * lane + 256 * j;
                const f32x4 gg = *(const f32x4*)(g + c), sc = *(const f32x4*)(mr + scoff + c), sh = *(const f32x4*)(mr + shoff + c);
                const f32x4 o = v[r][j] * rstd * gg * (sc + 1.0f) + sh; v2u w; w.x = pk2(o.x, o.y); w.y = pk2(o.z, o.w); *(v2u*)(U + (size_t)m * DM + c) = w; } } }
    }
    if (KRAW) { while (kval) KRAW_STEP(); }
#undef KRAW_STEP
}

#define MFMA32(a, b, c) __builtin_amdgcn_mfma_f32_32x32x16_bf16((a), (b), (c), 0, 0, 0)
__device__ __forceinline__ int crow(int r, int hi) { return (r & 3) + 8 * (r >> 2) + 4 * hi; }
__device__ __forceinline__ int t5_bucket_dev(int rel) {
    const int n = rel < 0 ? -rel : rel; const int ret = rel > 0 ? 16 : 0;
    int large = 8 + (int)(logf((float)(n > 1 ? n : 1) / 8.0f) / 4.852030263919617f * 8.0f);
    large = large < 15 ? large : 15;
    return ret + (n < 8 ? n : large);
}
__device__ __forceinline__ void load_raw(const bf16* p, v4u (&raw)[4]) {
#pragma unroll
    for (int kk = 0; kk < 4; ++kk) raw[kk] = *(const v4u*)(p + 16 * kk);
}
__device__ __forceinline__ void norm_frag(const v4u (&raw)[4], const float* gain, float mul, int hi, bool valid, bf16x8 (&f)[4]) {
    float ss = 0.f;
#pragma unroll
    for (int kk = 0; kk < 4; ++kk)
#pragma unroll
        for (int w = 0; w < 4; ++w) { const unsigned u = raw[kk][w]; const float lo = pg8::bf_lo(u), hv = pg8::bf_hi(u); ss += lo * lo + hv * hv; }
    ss += __shfl_xor(ss, 32);
    const float rstd = (valid ? mul : 0.f) / sqrtf(ss * (1.0f / 64.0f) + RMS_EPS);
#pragma unroll
    for (int kk = 0; kk < 4; ++kk) { const f32x4 g0 = *(const f32x4*)(gain + 8 * hi + 16 * kk) * rstd, g1 = *(const f32x4*)(gain + 8 * hi + 16 * kk + 4) * rstd;
        const v4u r4 = raw[kk];
        v4u o; o.x = pk2(pg8::bf_lo(r4.x) * g0.x, pg8::bf_hi(r4.x) * g0.y); o.y = pk2(pg8::bf_lo(r4.y) * g0.z, pg8::bf_hi(r4.y) * g0.w);
        o.z = pk2(pg8::bf_lo(r4.z) * g1.x, pg8::bf_hi(r4.z) * g1.y); o.w = pk2(pg8::bf_lo(r4.w) * g1.z, pg8::bf_hi(r4.w) * g1.w);
        f[kk] = __builtin_bit_cast(bf16x8, o); }
}
typedef short v4i16_t __attribute__((ext_vector_type(4)));
constexpr int ATT_PITCH = 144;
constexpr int ATT_BTW = 192;
constexpr int ATT_KOFF = 12 * ATT_BTW * 4, ATT_VOFF = ATT_KOFF + 384 * ATT_PITCH;
__device__ __forceinline__ void attn_phase(const Args& a, LAS unsigned char* lds, int bid, int G, int tid) {
    const int wave = tid >> 6, lane = tid & 63, ql = lane & 31, hi = lane >> 5;
    LAS float* BT = (LAS float*)lds;
    LAS unsigned char* Ks = lds + ATT_KOFF; LAS unsigned char* Vs = lds + ATT_VOFF;
    for (int idx = tid; idx < 12 * ATT_BTW; idx += 512) { const int h = idx / ATT_BTW, rel = idx % ATT_BTW - 95, g = h >> 2;
        BT[idx] = (rel >= -64 && rel <= 64) ? a.in[I_RELB][t5_bucket_dev(rel << (2 * g)) * 12 + h] * 1.4426950408889634f : -1.0e30f; }
    __syncthreads();
    const bf16* QKV = (const bf16*)(a.ws + WS_QKV);
    bf16* OG = (bf16*)(a.ws + WS_OG); float* LSE = (float*)(a.ws + WS_LSE);
    const int i16 = lane & 15, trq = i16 >> 2, trp = i16 & 3, blk = (lane >> 4) & 1;
    const int troff = (32 * wave + 4 * hi + trq) * ATT_PITCH + (16 * blk) * 2 + 8 * trp;
    const int srow = tid >> 3, sch = tid & 7;
#define ATT_DECODE(u_, rowbase_, h_, r_, Q0_, S_, dlog_) do { int grp_, bh_, w_, L_; \
        if ((u_) < 3072) { grp_ = 0; bh_ = (u_) >> 5; w_ = (u_) & 31; L_ = LP; } else { grp_ = 1; const int r2_ = (u_) - 3072; bh_ = r2_ >> 4; w_ = r2_ & 15; L_ = LS; } \
        const int b_ = bh_ / 12; h_ = bh_ % 12; dlog_ = 2 * (h_ >> 2); S_ = L_ >> dlog_; const int upr_ = S_ >> 8; r_ = w_ / upr_; Q0_ = (w_ % upr_) * 256; \
        rowbase_ = grp_ ? MP + b_ * LS : b_ * LP; } while (0)
#define ATT_LOADKV(rowbase_, h_, r_, Q0_, S_, dlog_, KLO, VLO, VHI) do { _Pragma("unroll") for (int p = 0; p < 6; ++p) { int sk = (Q0_) - 64 + 64 * p + srow; sk = sk < 0 ? 0 : (sk >= (S_) ? (S_) - 1 : sk); \
        const bf16* rp = QKV + ((size_t)(rowbase_) + ((size_t)sk << (dlog_)) + (r_)) * QW + (h_) * 64 + sch * 8; if (p >= (KLO)) kr[p] = *(const v4u*)(rp + 768); if (p >= (VLO) && p < (VHI)) vr[p] = *(const v4u*)(rp + 1536); } } while (0)
    v4u kr[6], vr[6], qr[4];
#define ATT_LOADQ(rowbase_, h_, r_, Q0_, dlog_) load_raw(QKV + ((size_t)(rowbase_) + ((size_t)((Q0_) + 32 * wave + ql) << (dlog_)) + (r_)) * QW + (h_) * 64 + 8 * hi, qr)
    const int avid = (G % 8 == 0) ? (bid >> 3) + (G >> 3) * (bid & 7) : bid;
    if (avid < 4608) { int rb, h, r, Q0, S, dlog; ATT_DECODE(avid, rb, h, r, Q0, S, dlog); ATT_LOADKV(rb, h, r, Q0, S, dlog, 0, 0, 6); ATT_LOADQ(rb, h, r, Q0, dlog); }
    for (int u = avid; u < 4608; u += G) {
        int rowbase, h, r, Q0, S, dlog; ATT_DECODE(u, rowbase, h, r, Q0, S, dlog);
        const int g = h >> 2, hh = h & 3, K0 = Q0 - 64;

        { const f32x4 g0 = *(const f32x4*)(a.in[I_KNG] + h * 64 + sch * 8), g1 = *(const f32x4*)(a.in[I_KNG] + h * 64 + sch * 8 + 4);
#pragma unroll
          for (int p = 0; p < 6; ++p) { const int kl = 64 * p + srow, sk = K0 + kl; const bool valid = sk >= 0 && sk < S;
              const v4u r4 = kr[p]; float ss = 0.f;
#pragma unroll
              for (int w4 = 0; w4 < 4; ++w4) { const float lo = pg8::bf_lo(r4[w4]), hv = pg8::bf_hi(r4[w4]); ss += lo * lo + hv * hv; }
              ss += __shfl_xor(ss, 1); ss += __shfl_xor(ss, 2); ss += __shfl_xor(ss, 4);
              const float rstd = valid ? 1.0f / sqrtf(ss * (1.0f / 64.0f) + RMS_EPS) : 0.f;
              v4u o; o.x = pk2(pg8::bf_lo(r4.x) * rstd * g0.x, pg8::bf_hi(r4.x) * rstd * g0.y); o.y = pk2(pg8::bf_lo(r4.y) * rstd * g0.z, pg8::bf_hi(r4.y) * rstd * g0.w);
              o.z = pk2(pg8::bf_lo(r4.z) * rstd * g1.x, pg8::bf_hi(r4.z) * rstd * g1.y); o.w = pk2(pg8::bf_lo(r4.w) * rstd * g1.z, pg8::bf_hi(r4.w) * rstd * g1.w);
              *(LAS v4u*)(Ks + kl * ATT_PITCH + sch * 16) = o; *(LAS v4u*)(Vs + kl * ATT_PITCH + sch * 16) = vr[p]; }
        }
        const int q0 = Q0 + 32 * wave;
        bf16x8 qf[4];
        norm_frag(qr, a.in[I_QNG] + h * 64, 0.125f * 1.4426950408889634f, hi, true, qf);
        { const int un = u + G; if (un < 4608) { int rb, h2, r2, Q02, S2, dlog2; ATT_DECODE(un, rb, h2, r2, Q02, S2, dlog2); ATT_LOADKV(rb, h2, r2, Q02, S2, dlog2, 0, 0, 6); ATT_LOADQ(rb, h2, r2, Q02, dlog2); } }
        __syncthreads();
        f32x16 st[5];
#pragma unroll
        for (int j = 0; j < 5; ++j) {
            const LAS unsigned char* kp = Ks + (32 * wave + 32 * j + ql) * ATT_PITCH + (8 * hi) * 2;
            f32x16 acc;
#pragma unroll
            for (int i = 0; i < 16; ++i) acc[i] = 0.f;
#pragma unroll
            for (int kk = 0; kk < 4; ++kk) acc = MFMA32(*(const LAS bf16x8*)(kp + 32 * kk), qf[kk], acc);
            st[j] = acc;
        }
        const LAS float* btl = BT + h * ATT_BTW + 31 - ql + 4 * hi;
        const int vlo = K0 < 0 ? -K0 : 0, vhi = (S - K0) < 384 ? (S - K0) : 384;
        const int klb = 32 * wave + 4 * hi - vlo; const unsigned vspan = (unsigned)(vhi - vlo);
        float mx = -3.0e38f;
#pragma unroll
        for (int j = 0; j < 5; ++j)
#pragma unroll
            for (int i = 0; i < 16; ++i) {
                const int cji = 32 * j + (i & 3) + 8 * (i >> 2);
                float sv = st[j][i] + btl[cji];
                sv = ((unsigned)(klb + cji) < vspan) ? sv : -1.0e30f;
                st[j][i] = sv; mx = fmaxf(mx, sv);
            }
        mx = fmaxf(mx, __shfl_xor(mx, 32));
        float den = 0.f;
#pragma unroll
        for (int j = 0; j < 5; ++j)
#pragma unroll
            for (int i = 0; i < 16; ++i) { const float p = __builtin_amdgcn_exp2f(st[j][i] - mx); st[j][i] = p; den += p; }
        den += __shfl_xor(den, 32);
        f32x16 ot[2];
#pragma unroll
        for (int i = 0; i < 16; ++i) { ot[0][i] = 0.f; ot[1][i] = 0.f; }
#pragma unroll
        for (int j = 0; j < 5; ++j) {
#pragma unroll
            for (int kk2 = 0; kk2 < 2; ++kk2) {
                v4u pb; pb.x = pk2(st[j][8 * kk2 + 0], st[j][8 * kk2 + 1]); pb.y = pk2(st[j][8 * kk2 + 2], st[j][8 * kk2 + 3]);
                pb.z = pk2(st[j][8 * kk2 + 4], st[j][8 * kk2 + 5]); pb.w = pk2(st[j][8 * kk2 + 6], st[j][8 * kk2 + 7]);
                const bf16x8 pfrag = __builtin_bit_cast(bf16x8, pb);
#pragma unroll
                for (int dt = 0; dt < 2; ++dt) {
                    LAS unsigned char* tp = Vs + troff + (32 * j + 16 * kk2) * ATT_PITCH + (32 * dt) * 2;
                    const v4i16_t lo = __builtin_amdgcn_ds_read_tr16_b64_v4i16((LAS v4i16_t*)tp);
                    const v4i16_t hv = __builtin_amdgcn_ds_read_tr16_b64_v4i16((LAS v4i16_t*)(tp + 8 * ATT_PITCH));
                    const bf16x8 av = __builtin_shufflevector(lo, hv, 0, 1, 2, 3, 4, 5, 6, 7);
                    ot[dt] = MFMA32(av, pfrag, ot[dt]);
                }
            }
        }
        const float inv = 1.0f / den;
        const size_t orow = (size_t)rowbase + ((size_t)(q0 + ql) << dlog) + r;
        bf16* op = OG + ((size_t)g * MT + orow) * 256 + hh * 64;
#pragma unroll
        for (int dt = 0; dt < 2; ++dt)
#pragma unroll
            for (int pr = 0; pr < 2; ++pr) { const int ie = 2 * pr, io = 2 * pr + 1;
                const unsigned e0 = pk2(ot[dt][4 * ie] * inv, ot[dt][4 * ie + 1] * inv), e1 = pk2(ot[dt][4 * ie + 2] * inv, ot[dt][4 * ie + 3] * inv);
                const unsigned o0 = pk2(ot[dt][4 * io] * inv, ot[dt][4 * io + 1] * inv), o1 = pk2(ot[dt][4 * io + 2] * inv, ot[dt][4 * io + 3] * inv);
                const auto s0 = __builtin_amdgcn_permlane32_swap(e0, o0, false, false), s1 = __builtin_amdgcn_permlane32_swap(e1, o1, false, false);
                v4u w4; w4.x = s0[0]; w4.y = s1[0]; w4.z = s0[1]; w4.w = s1[1];
                *(v4u*)(op + 32 * dt + 8 * (2 * pr + hi)) = w4; }
        if (hi == 0) LSE[((size_t)g * MT + orow) * 4 + hh] = (mx + __log2f(den)) * 0.6931471805599453f;
        __syncthreads();
    }
}
__device__ __forceinline__ void merge_rows(const Args& a, int gw, int NGW, int lane) {
    const bf16* OG = (const bf16*)(a.ws + WS_OG); const float* LSE = (const float*)(a.ws + WS_LSE); bf16* YAT = (bf16*)(a.ws + WS_YAT);
    const int hh = lane >> 4;
    for (int mb = gw; mb < MT; mb += 4 * NGW) {
        float l[4][3]; v2u o[4][3];
#pragma unroll
        for (int r = 0; r < 4; ++r) { const int m = mb + r * NGW; const int mc = m < MT ? m : mb;
#pragma unroll
            for (int g = 0; g < 3; ++g) { l[r][g] = LSE[((size_t)g * MT + mc) * 4 + hh]; o[r][g] = *(const v2u*)(OG + ((size_t)g * MT + mc) * 256 + 4 * lane); } }
#pragma unroll
        for (int r = 0; r < 4; ++r) { const int m = mb + r * NGW; if (m < MT) {
            const float mxl = fmaxf(l[r][0], fmaxf(l[r][1], l[r][2]));
            float a0 = __expf(l[r][0] - mxl), a1 = __expf(l[r][1] - mxl), a2 = __expf(l[r][2] - mxl); const float is = 1.0f / (a0 + a1 + a2); a0 *= is; a1 *= is; a2 *= is;
            const v2u o0 = o[r][0], o1 = o[r][1], o2 = o[r][2];
            v2u w;
            w.x = pk2(a0 * pg8::bf_lo(o0.x) + a1 * pg8::bf_lo(o1.x) + a2 * pg8::bf_lo(o2.x), a0 * pg8::bf_hi(o0.x) + a1 * pg8::bf_hi(o1.x) + a2 * pg8::bf_hi(o2.x));
            w.y = pk2(a0 * pg8::bf_lo(o0.y) + a1 * pg8::bf_lo(o1.y) + a2 * pg8::bf_lo(o2.y), a0 * pg8::bf_hi(o0.y) + a1 * pg8::bf_hi(o1.y) + a2 * pg8::bf_hi(o2.y));
            *(v2u*)(YAT + (size_t)m * 256 + 4 * lane) = w; } }
    }
}

constexpr int HT_PITCH = 260;
constexpr int HW_OFF = 40960;
__device__ __forceinline__ void hy_weights_to_lds(const Args& a, LAS unsigned char* lds, int tid) {
    LAS float* W = (LAS float*)(lds + HW_OFF);
    for (int i = tid; i < 3 * ZW; i += 512) W[i] = a.in[I_CONVW][i];
    for (int i = tid; i < ZW; i += 512) W[3 * ZW + i] = a.in[I_CONVB][i];
    __syncthreads();
}
__device__ __forceinline__ void hy_load6(const bf16* ZHY, int col, int mr0, int L, v4u (&z)[6]) {
    const bool lv = (mr0 & (L - 1)) != 0, rv = ((mr0 + 4) & (L - 1)) != 0;
#pragma unroll
    for (int i = 0; i < 6; ++i) { const bool ok = (i == 0) ? lv : (i == 5 ? rv : true);
        v4u u = {0u, 0u, 0u, 0u}; if (ok) u = *(const v4u*)(ZHY + (size_t)(mr0 + i - 1) * ZW + col); z[i] = u; }
}
__device__ __forceinline__ void hy_conv4x8(const v4u (&z)[6], const LAS float* W, int col, float (&o)[4][8]) {
    float w0[8], w1[8], w2[8], bb[8];
#pragma unroll
    for (int h4 = 0; h4 < 2; ++h4) { const f32x4 a0 = *(const LAS f32x4*)(W + col + 4 * h4), a1 = *(const LAS f32x4*)(W + ZW + col + 4 * h4), a2 = *(const LAS f32x4*)(W + 2 * ZW + col + 4 * h4), a3 = *(const LAS f32x4*)(W + 3 * ZW + col + 4 * h4);
#pragma unroll
        for (int k = 0; k < 4; ++k) { w0[4 * h4 + k] = a0[k]; w1[4 * h4 + k] = a1[k]; w2[4 * h4 + k] = a2[k]; bb[4 * h4 + k] = a3[k]; } }
#pragma unroll
    for (int j = 0; j < 4; ++j)
#pragma unroll
        for (int k = 0; k < 4; ++k) {
            o[j][2 * k]     = pg8::bf_lo(z[j][k]) * w0[2 * k]     + pg8::bf_lo(z[j + 1][k]) * w1[2 * k]     + pg8::bf_lo(z[j + 2][k]) * w2[2 * k]     + bb[2 * k];
            o[j][2 * k + 1] = pg8::bf_hi(z[j][k]) * w0[2 * k + 1] + pg8::bf_hi(z[j + 1][k]) * w1[2 * k + 1] + pg8::bf_hi(z[j + 2][k]) * w2[2 * k + 1] + bb[2 * k + 1]; }
}
__device__ __forceinline__ void hyena_prep(const Args& a, LAS unsigned char* lds, int bid, int G, int tid) {
    const bf16* ZHY = (const bf16*)(a.ws + WS_ZHY); bf16* UCT = (bf16*)(a.ws + WS_UCT);
    LAS unsigned short* tile = (LAS unsigned short*)lds; const LAS float* W = (const LAS float*)(lds + HW_OFF);
    const int cg = tid & 7, tq = tid >> 3, NT = (MT / 256) * 12;
    hy_weights_to_lds(a, lds, tid);
    v4u n1[6], nv[6];
    if (bid < NT) { const int m0 = (bid / 12) * 256, c0 = (bid % 12) * 64, L = m0 < MP ? LP : LS; hy_load6(ZHY, 768 + c0 + 8 * cg, m0 + 4 * tq, L, n1); hy_load6(ZHY, 1536 + c0 + 8 * cg, m0 + 4 * tq, L, nv); }
    for (int it = bid; it < NT; it += G) {
        const int m0 = (it / 12) * 256, c0 = (it % 12) * 64, ca = c0 + 8 * cg;
        v4u z1[6], zv[6];
#pragma unroll
        for (int i = 0; i < 6; ++i) { z1[i] = n1[i]; zv[i] = nv[i]; }
        { const int itn = it + G; if (itn < NT) { const int m0n = (itn / 12) * 256, c0n = (itn % 12) * 64, Ln = m0n < MP ? LP : LS; hy_load6(ZHY, 768 + c0n + 8 * cg, m0n + 4 * tq, Ln, n1); hy_load6(ZHY, 1536 + c0n + 8 * cg, m0n + 4 * tq, Ln, nv); } }
        float x1[4][8], vv[4][8];
        hy_conv4x8(z1, W, 768 + ca, x1); hy_conv4x8(zv, W, 1536 + ca, vv);
#pragma unroll
        for (int i = 0; i < 8; ++i) { v2u w; w.x = pk2(x1[0][i] * vv[0][i], x1[1][i] * vv[1][i]); w.y = pk2(x1[2][i] * vv[2][i], x1[3][i] * vv[3][i]);
            *(LAS v2u*)(tile + (8 * cg + i) * HT_PITCH + 4 * tq) = w; }
        __syncthreads();
        { const int c = tid >> 3, piece = tid & 7;
          const LAS v2u* sp = (const LAS v2u*)(tile + c * HT_PITCH + piece * 32);
          v4u* dp = (v4u*)(UCT + (size_t)(c0 + c) * MT + m0 + piece * 32);
#pragma unroll
          for (int k = 0; k < 4; ++k) { const v2u lo = sp[2 * k], hv = sp[2 * k + 1]; v4u o; o.x = lo.x; o.y = lo.y; o.z = hv.x; o.w = hv.y; dp[k] = o; } }
        __syncthreads();
    }
}
__device__ __forceinline__ void hyena_gate(const Args& a, LAS unsigned char* lds, int bid, int G, int tid) {
    const bf16* ZHY = (const bf16*)(a.ws + WS_ZHY); const bf16* UCT = (const bf16*)(a.ws + WS_UCT); bf16* YH = (bf16*)(a.ws + WS_YH);
    LAS unsigned short* tile = (LAS unsigned short*)lds; const LAS float* W = (const LAS float*)(lds + HW_OFF);
    const int cg = tid & 7, tq = tid >> 3, NT = (MT / 256) * 12, yc = tid >> 3, yp = tid & 7;
    hy_weights_to_lds(a, lds, tid);
    v4u n0[6], ny[4];
    if (bid < NT) { const int m0 = (bid / 12) * 256, c0 = (bid % 12) * 64, L = m0 < MP ? LP : LS; hy_load6(ZHY, c0 + 8 * cg, m0 + 4 * tq, L, n0);
        const v4u* dp = (const v4u*)(UCT + (size_t)(c0 + yc) * MT + m0 + yp * 32);
#pragma unroll
        for (int k = 0; k < 4; ++k) ny[k] = dp[k]; }
    for (int it = bid; it < NT; it += G) {
        const int m0 = (it / 12) * 256, c0 = (it % 12) * 64, mr0 = m0 + 4 * tq, ca = c0 + 8 * cg;
        v4u z0[6];
#pragma unroll
        for (int i = 0; i < 6; ++i) z0[i] = n0[i];
        { LAS v2u* sp = (LAS v2u*)(tile + yc * HT_PITCH + yp * 32);
#pragma unroll
          for (int k = 0; k < 4; ++k) { const v4u o = ny[k]; v2u lo, hv; lo.x = o.x; lo.y = o.y; hv.x = o.z; hv.y = o.w; sp[2 * k] = lo; sp[2 * k + 1] = hv; } }
        { const int itn = it + G; if (itn < NT) { const int m0n = (itn / 12) * 256, c0n = (itn % 12) * 64, Ln = m0n < MP ? LP : LS; hy_load6(ZHY, c0n + 8 * cg, m0n + 4 * tq, Ln, n0);
            const v4u* dp = (const v4u*)(UCT + (size_t)(c0n + yc) * MT + m0n + yp * 32);
#pragma unroll
            for (int k = 0; k < 4; ++k) ny[k] = dp[k]; } }
        float x0[4][8];
        hy_conv4x8(z0, W, ca, x0);
        __syncthreads();
        float y[4][8];
#pragma unroll
        for (int i = 0; i < 8; ++i) { const v2u w = *(const LAS v2u*)(tile + (8 * cg + i) * HT_PITCH + 4 * tq);
            y[0][i] = pg8::bf_lo(w.x); y[1][i] = pg8::bf_hi(w.x); y[2][i] = pg8::bf_lo(w.y); y[3][i] = pg8::bf_hi(w.y); }
#pragma unroll
        for (int j = 0; j < 4; ++j) { v4u o;
#pragma unroll
            for (int k = 0; k < 4; ++k) o[k] = pk2(x0[j][2 * k] * y[j][2 * k], x0[j][2 * k + 1] * y[j][2 * k + 1]);
            *(v4u*)(YH + (size_t)(mr0 + j) * DH + ca) = o; }
        __syncthreads();
    }
}

#define FFT_LD(IDX) do { _Pragma("unroll") for (int e = 0; e < 32; ++e) v[e] = X[IDX(tl_, e)]; } while (0)
#define FFT_ST(IDX) do { _Pragma("unroll") for (int e = 0; e < 32; ++e) X[IDX(tl_, e)] = v[e]; } while (0)
#define FFT_PASS() const int tl_ = lnd(tid)
typedef cf2 f32x2v;
__device__ __forceinline__ int fft_pA(int t, int e) { return ((t ^ (t >> 5)) ^ (16 * (e & 1))) + 512 * e; }
__device__ __forceinline__ int fft_pB(int t, int e) { return ((t >> 4) << 9) + 32 * (e >> 1) + (((t & 15) ^ (e >> 1)) + 16 * ((e & 1) ^ ((t >> 4) & 1))); }
__device__ __forceinline__ int fft_pC(int t, int e) { return 32 * t + (e ^ (t & 31)); }
__device__ __forceinline__ void kraw_items(const Args& a, int gw, int NGW, int lane) {
    const float* H3 = (const float*)(a.ws + WS_H3); float* KR = (float*)(a.ws + WS_KRAW);
    for (int it = gw; it < 192 * 32; it += NGW) {
        const int pg = it >> 5, cgp = it & 31, p = pg * 64 + lane, c0 = cgp * 48;
        float h[64];
#pragma unroll
        for (int q = 0; q < 16; ++q) { const f32x4 t = *(const f32x4*)(H3 + (size_t)p * 64 + 4 * q); h[4 * q] = t.x; h[4 * q + 1] = t.y; h[4 * q + 2] = t.z; h[4 * q + 3] = t.w; }
        const int grp = p >= LP, tpos = p - grp * LP, L = grp ? LS : LP;
        const float tt = (float)tpos * (1.0f / (float)(L - 1));
#pragma unroll 1
        for (int cb = 0; cb < 4; ++cb) {
            const float* wr = a.in[I_FWOUT] + lane * 1536 + c0 + 12 * cb;
            const f32x4 w0 = *(const f32x4*)(wr), w1 = *(const f32x4*)(wr + 4), w2 = *(const f32x4*)(wr + 8);
            float wv[12] = {w0.x, w0.y, w0.z, w0.w, w1.x, w1.y, w1.z, w1.w, w2.x, w2.y, w2.z, w2.w};
#pragma unroll
            for (int ci = 0; ci < 12; ++ci) { const int c = c0 + 12 * cb + ci;
                float acc = 0.f;
#pragma unroll
                for (int jj = 0; jj < 64; ++jj) acc += h[jj] * __builtin_bit_cast(float, __builtin_amdgcn_readlane(__builtin_bit_cast(int, wv[ci]), jj));
                const int cm = c % 768;
                const float delta = fabsf(-3.0701134573253945f + (float)cm * ((-15.350567286626973f + 3.0701134573253945f) / 767.0f));
                KR[(size_t)c * (LP + LS) + p] = acc * __expf(-tt * delta); }
        }
    }
}
__device__ __forceinline__ void filter_phase(const Args& a, LAS unsigned char* lds, int bid, int G, int tid) {
    LAS f32x2v* X = (LAS f32x2v*)lds;
    LAS float* red = (LAS float*)(lds + 131072);
    const float* KR = (const float*)(a.ws + WS_KRAW);
    unsigned* KS = (unsigned*)(a.ws + WS_KSPEC);
    const int lane = tid & 63, wave = tid >> 6;
    for (int it = bid; it < 1536; it += G) {
        const int grp = it >= 768, c = it - grp * 768, L = grp ? LS : LP;
        const float* kf = KR + (size_t)c * (LP + LS) + grp * LP; const float* kb = kf + (size_t)768 * (LP + LS);
        cf2 v[32]; float asum = 0.f;
        { const int tl = lnd(tid);
#pragma unroll
          for (int e = 0; e < 32; ++e) {
            const int i = tl + 512 * e; float val = 0.f;
            if (e < 16) { if (i < L) val = kf[i]; } else { const int tp = 16384 - i; if (tp >= 1 && tp <= L - 1) val = kb[tp]; }
            v[e].x = val; v[e].y = 0.f; asum += fabsf(val);
          } }
        asum = wave_sum(asum);
        if (lane == 0) red[wave] = asum;
        __syncthreads();
        float tot = 0.f;
#pragma unroll
        for (int w = 0; w < 8; ++w) tot += red[w];
        const float sc = 1.0f / (tot * 16384.0f), dd = a.in[I_HYD][c] * (1.0f / 16384.0f);
        { FFT_PASS(); dif_stages<5, 0>(v, tl_, 9); FFT_ST(fft_pA); } __syncthreads();
        { FFT_PASS(); FFT_LD(fft_pB); dif_stages<5, 0>(v, tl_ & 15, 4); FFT_ST(fft_pB); } __syncthreads();
        { FFT_PASS(); FFT_LD(fft_pC); dif_stages<4, 0, true>(v, 0, 0); dif_stages<4, 16, true>(v, 0, 0);
          unsigned* kp = KS + (size_t)it * 16384 + tl_;
#pragma unroll
          for (int e = 0; e < 32; ++e) kp[e * 512] = pk2(v[e].x * sc + dd, v[e].y * sc); }
        __syncthreads();
    }
}
struct FftItem { int rowA, rowB, offB, kidx; unsigned short* base; };
__device__ __forceinline__ void fft_item(int it, bf16* UCT, FftItem& I, int& r0, int& r1, int& r2, int& r3, int& f1) {
    if (it < 3072) { const int c = it >> 2, bp = it & 3; r0 = (2 * bp) * LP; r1 = r0 + LP; r2 = r0 + 4096; r3 = r1 + 4096; f1 = 4096; I.kidx = c; I.base = UCT + (size_t)c * MT; }
    else { const int j = it - 3072, c = j >> 1, half = j & 1; r0 = MP + (4 * half) * LS; r1 = r0 + LS; r2 = r0 + 2 * LS; r3 = r2 + LS; f1 = 8192; I.kidx = 768 + c; I.base = UCT + (size_t)c * MT; }
}
__device__ __forceinline__ void fftconv_phase(const Args& a, LAS unsigned char* lds, int bid, int G, int tid) {
    LAS f32x2v* X = (LAS f32x2v*)lds;
    bf16* UCT = (bf16*)(a.ws + WS_UCT);
    const unsigned* KS = (const unsigned*)(a.ws + WS_KSPEC);
    const int vid = (G % 8 == 0) ? (bid >> 3) + (G >> 3) * (bid & 7) : bid;
    v4u nx[4];
    { FftItem I; int r0, r1, r2, r3, f1; if (vid < 4608) { fft_item(vid, UCT, I, r0, r1, r2, r3, f1); const int t8 = 8 * lnd(tid);
        nx[0] = *(const v4u*)(I.base + r0 + t8); nx[1] = *(const v4u*)(I.base + r1 + t8); nx[2] = *(const v4u*)(I.base + r2 + t8); nx[3] = *(const v4u*)(I.base + r3 + t8); } }
    for (int it = vid; it < 4608; it += G) {
        FftItem I; int r0, r1, r2, r3, f1; fft_item(it, UCT, I, r0, r1, r2, r3, f1);
        { const int tl = lnd(tid); const f32x2v z = {0.f, 0.f};
#pragma unroll
          for (int k = 0; k < 4; ++k) { f32x2v s0, s1, s2, s3;
              s0.x = pg8::bf_lo(nx[0][k]); s0.y = pg8::bf_lo(nx[1][k]); s1.x = pg8::bf_hi(nx[0][k]); s1.y = pg8::bf_hi(nx[1][k]);
              s2.x = pg8::bf_lo(nx[2][k]); s2.y = pg8::bf_lo(nx[3][k]); s3.x = pg8::bf_hi(nx[2][k]); s3.y = pg8::bf_hi(nx[3][k]);
              X[fft_swz(8 * tl + 2 * k)] = s0; X[fft_swz(8 * tl + 2 * k + 1)] = s1; X[fft_swz(f1 + 8 * tl + 2 * k)] = s2; X[fft_swz(f1 + 8 * tl + 2 * k + 1)] = s3; }
          const int z0 = (f1 == 4096) ? 8192 : 4096, z1 = 12288;
#pragma unroll
          for (int k = 0; k < 8; ++k) { X[fft_swz(z0 + tl + 512 * k)] = z; X[fft_swz(z1 + tl + 512 * k)] = z; } }
        { const int itn = it + G; if (itn < 4608) { FftItem J; int q0, q1, q2, q3, g1; fft_item(itn, UCT, J, q0, q1, q2, q3, g1); const int t8 = 8 * lnd(tid);
            nx[0] = *(const v4u*)(J.base + q0 + t8); nx[1] = *(const v4u*)(J.base + q1 + t8); nx[2] = *(const v4u*)(J.base + q2 + t8); nx[3] = *(const v4u*)(J.base + q3 + t8); } }
        __syncthreads();
        cf2 v[32];
        { FFT_PASS(); FFT_LD(fft_pA); dif_stages<5, 0>(v, tl_, 9); FFT_ST(fft_pA); } __syncthreads();
        unsigned kq[32];
        { const unsigned* kp = KS + (size_t)I.kidx * 16384 + lnd(tid);
#pragma unroll
          for (int e = 0; e < 32; ++e) kq[e] = kp[e * 512]; }
        { FFT_PASS(); FFT_LD(fft_pB); dif_stages<5, 0>(v, tl_ & 15, 4); FFT_ST(fft_pB); } __syncthreads();
        { FFT_PASS(); FFT_LD(fft_pC); dif_stages<4, 0, true>(v, 0, 0); dif_stages<4, 16, true>(v, 0, 0);
#pragma unroll
          for (int e = 0; e < 32; ++e) { f32x2v kk; kk.x = pg8::bf_lo(kq[e]); kk.y = pg8::bf_hi(kq[e]); v[e] = cmul(v[e], kk); }
          dit_stages<4, 0, true>(v, 0, 0); dit_stages<4, 16, true>(v, 0, 0); FFT_ST(fft_pC); } __syncthreads();
        { FFT_PASS(); FFT_LD(fft_pB); dit_stages<5, 0>(v, tl_ & 15, 4); FFT_ST(fft_pB); } __syncthreads();
        { FFT_PASS(); FFT_LD(fft_pA); dit_stages<5, 0>(v, tl_, 9); FFT_ST(fft_pA); } __syncthreads();
        { const int tl = lnd(tid); v4u o0, o1, o2, o3;
#pragma unroll
          for (int k = 0; k < 4; ++k) { const f32x2v s0 = X[fft_swz(8 * tl + 2 * k)], s1 = X[fft_swz(8 * tl + 2 * k + 1)], s2 = X[fft_swz(f1 + 8 * tl + 2 * k)], s3 = X[fft_swz(f1 + 8 * tl + 2 * k + 1)];
              o0[k] = pk2(s0.x, s1.x); o1[k] = pk2(s0.y, s1.y); o2[k] = pk2(s2.x, s3.x); o3[k] = pk2(s2.y, s3.y); }
          *(v4u*)(I.base + r0 + 8 * tl) = o0; *(v4u*)(I.base + r1 + 8 * tl) = o1; *(v4u*)(I.base + r2 + 8 * tl) = o2; *(v4u*)(I.base + r3 + 8 * tl) = o3; }
        __syncthreads();
    }
}

#define XB_TMO      128
#define XB_XCNT(j)  (256  + 64 * (j))
#define XB_XSUB(j)  (1280 + 64 * (j))
#define XB_XGEN(j)  (2304 + 64 * (j))
#define XB_TOP      3328
#define XB_TOPGEN   3392
#define XCD_BAR_WORDS 3456
#define XB_SPIN_CAP (1u << 18)

__device__ __forceinline__ unsigned xb_ld(unsigned* p)              { return __hip_atomic_load(p, __ATOMIC_RELAXED, __HIP_MEMORY_SCOPE_AGENT); }
__device__ __forceinline__ unsigned xb_add(unsigned* p, unsigned v) { return __hip_atomic_fetch_add(p, v, __ATOMIC_RELAXED, __HIP_MEMORY_SCOPE_AGENT); }
__device__ __forceinline__ unsigned xb_xcc_id() { return (unsigned)__builtin_amdgcn_s_getreg((3 << 11) | 20) & 0xFu; }
#define XB_SPIN(cond, bar) do { unsigned _sp = 0; while (cond) { __builtin_amdgcn_s_sleep(1); \
    if ((++_sp & 255u) == 0u) { if (xb_ld(&(bar)[XB_TMO])) break; if (_sp > XB_SPIN_CAP) { atomicAdd(&(bar)[XB_TMO], 1u); break; } } } } while (0)

struct XcdBarrier {
    unsigned* bar; unsigned x;
    volatile LAS unsigned* st;
};

__device__ __forceinline__ XcdBarrier xcd_barrier_post(unsigned* bar, volatile LAS unsigned* st) {
    XcdBarrier b; b.bar = bar; b.x = xb_xcc_id(); b.st = st;
    if (threadIdx.x == 0) (void)xb_add(&bar[XB_XCNT(b.x)], 1u);
    return b;
}
__device__ __forceinline__ void xcd_barrier_complete(unsigned* bar, unsigned x, unsigned& nloc, unsigned& nx) {
    const unsigned G = gridDim.x * gridDim.y * gridDim.z;
    unsigned sum, cnt, mine, sp = 0u;
    for (;;) {
        sum = 0u; cnt = 0u; mine = 0u;
#pragma unroll
        for (unsigned j = 0; j < 16; ++j) { const unsigned c = xb_ld(&bar[XB_XCNT(j)]); sum += c; cnt += (c > 0u) ? 1u : 0u; mine = (j == x) ? c : mine; }
        if (sum == G) break;
        __builtin_amdgcn_s_sleep(1);
        if ((++sp & 255u) == 0u) { if (xb_ld(&bar[XB_TMO])) break; if (sp > XB_SPIN_CAP) { atomicAdd(&bar[XB_TMO], 1u); break; } }
    }
    nloc = mine > 0u ? mine : 1u; nx = cnt > 0u ? cnt : 1u;
}

__device__ __forceinline__ void xcd_barrier(const XcdBarrier& b) {
    asm volatile("s_waitcnt vmcnt(0)" ::: "memory");
    __syncthreads();
    if (threadIdx.x == 0) {
        unsigned* bar = b.bar;
        __builtin_amdgcn_s_waitcnt(0);
        unsigned nloc = b.st[0], nx = b.st[1];
        if (nloc == 0u) { xcd_barrier_complete(bar, b.x, nloc, nx); b.st[0] = nloc; b.st[1] = nx; }
        const unsigned old = xb_add(&bar[XB_XSUB(b.x)], 1u);
        const unsigned gen = old / nloc;
        if (old + 1u == (gen + 1u) * nloc) {
            __builtin_amdgcn_fence(__ATOMIC_RELEASE, "agent");
            asm volatile("s_waitcnt vmcnt(0)" ::: "memory");
            const unsigned og = xb_add(&bar[XB_TOP], 1u);
            const unsigned tg = og / nx;
            if (og + 1u == (tg + 1u) * nx) xb_add(&bar[XB_TOPGEN], 1u);
            else XB_SPIN(xb_ld(&bar[XB_TOPGEN]) == tg, bar);
            __builtin_amdgcn_fence(__ATOMIC_ACQUIRE, "agent");
            xb_add(&bar[XB_XGEN(b.x)], 1u);
            asm volatile("s_waitcnt vmcnt(0)" ::: "memory");
        } else {
            XB_SPIN(xb_ld(&bar[XB_XGEN(b.x)]) == gen, bar);
            __builtin_amdgcn_fence(__ATOMIC_ACQUIRE, "agent");
            asm volatile("s_waitcnt vmcnt(0)" ::: "memory");
        }
    }
    __syncthreads();
}

template <int PHM> __global__ void __launch_bounds__(512, 2) mk_fwd(Args karg) {
    extern __shared__ __attribute__((aligned(16))) unsigned char lds_raw[];
    LAS unsigned char* lds = (LAS unsigned char*)lds_raw;
    const int bid = blockIdx.x, G = gridDim.x, NGW = G * 8;
#define PH_IDS() const int tid = lnd((int)threadIdx.x), lane = tid & 63, wave = __builtin_amdgcn_readfirstlane(tid >> 6), gw = bid * 8 + wave; (void)lane; (void)gw
    typedef const __attribute__((address_space(4))) Args* KArgs;
    KArgs kp = (KArgs)__builtin_amdgcn_kernarg_segment_ptr();
#define PH_ARGS() KArgs kq_ = kp; asm volatile("" : "+s"(kq_)); const Args a = *(const Args*)kq_; unsigned char* ws = a.ws; const float* MOD = (const float*)(ws + WS_MOD); \
    bf16* WIN = (bf16*)(ws + WS_WIN); bf16* WHB = (bf16*)(ws + WS_WHB); bf16* WAB = (bf16*)(ws + WS_WAB); bf16* WOUT = (bf16*)(ws + WS_WOUT); bf16* WUP = (bf16*)(ws + WS_WUP); bf16* WDN = (bf16*)(ws + WS_WDN); \
    (void)MOD; (void)WIN; (void)WHB; (void)WAB; (void)WOUT; (void)WUP; (void)WDN
    constexpr bool MULTI = (PHM & (PHM - 1)) != 0;
    XcdBarrier xbar; xbar.bar = (unsigned*)(karg.ws + WS_BAR); xbar.x = 0; xbar.st = nullptr;
    if constexpr (MULTI) {
        volatile LAS unsigned* stw = (volatile LAS unsigned*)(lds + LDS_BYTES - 64);
        if (threadIdx.x < 2) stw[threadIdx.x] = 0u;
        __syncthreads();
        xbar = xcd_barrier_post((unsigned*)(karg.ws + WS_BAR), stw);
    }
#define GRID_SYNC(k) do { if constexpr (MULTI) { if ((k) == 0) cg::this_grid().sync(); else xcd_barrier(xbar); } } while (0)
#define IN(k) (((PHM >> (k)) & 1) && karg.ph_lo <= (k) && (k) < karg.ph_hi)
#ifndef REP_MASK
#define REP_MASK 0
#endif
#define REPS(k) for (int rep_ = 0; rep_ < (((REP_MASK >> (k)) & 1) ? 2 : 1); ++rep_)
#define SEAM(k) do { if (IN(k) && IN((k) + 1)) GRID_SYNC(k); } while (0)

    if (IN(0)) REPS(0) { PH_ARGS(); PH_IDS();
        p0_mod(a, lds, bid, G, tid);
        LAS float* scr = (LAS float*)(lds + wave * 16384);
        constexpr int I_IN = (DM / 64) * (NIN / 32), I_HB = (DH / 64) * (DM / 32), I_AB = (256 / 64) * (DM / 32), I_OUT = (DM / 64) * (DM / 32), I_UP = (DM / 64) * (DFF / 32), I_DN = (DFF / 64) * (DM / 32);
        constexpr int NITEMS = I_IN + I_HB + I_AB + I_OUT + I_UP + I_DN;
        for (int it = gw; it < NITEMS; it += NGW) {
            int r = it;
            if (r < I_IN) { const int n0 = 32 * (r % (NIN / 32)); const int off = n0 < 2304 ? 3072 : (n0 < 5376 ? -2304 : 0);
                p0_transpose_item(a.in[I_WIN], DM, NIN, WIN, off, scr, r, lane); continue; } r -= I_IN;
            if (r < I_HB) { p0_transpose_item(a.in[I_WHB], DH, DM, WHB, 0, scr, r, lane); continue; } r -= I_HB;
            if (r < I_AB) { p0_transpose_item(a.in[I_WAB], 256, DM, WAB, 0, scr, r, lane); continue; } r -= I_AB;
            if (r < I_OUT) { p0_transpose_item(a.in[I_WOUT], DM, DM, WOUT, 0, scr, r, lane); continue; } r -= I_OUT;
            if (r < I_UP) { p0_transpose_item(a.in[I_WUP], DM, DFF, WUP, 0, scr, r, lane); continue; } r -= I_UP;
            p0_transpose_item(a.in[I_WDN], DFF, DM, WDN, 0, scr, r, lane);
        }
        p0_h3(a, gw, NGW, lane);
        __syncthreads();
    }
    SEAM(0);
    if (IN(1)) REPS(1) { PH_ARGS(); PH_IDS(); prep_rows<false, true>(a.in[I_XP], a.in[I_XS], nullptr, a.in[I_N1G], MOD, 0, 1024, (bf16*)(ws + WS_U1), gw, NGW, lane, a.in[I_FWOUT], (const float*)(ws + WS_H3), (float*)(ws + WS_KRAW)); }
    SEAM(1);
    if (IN(2)) REPS(2) { PH_ARGS();
        pg8::Gemm g{(const bf16*)(ws + WS_U1), WIN, MT, QW + 768, DM}; pg8::StaticOrder S; S.init(MT, QW + 768, G, bid);
        pg8::EpiB<1> E{(bf16*)(ws + WS_QKV), QW, nullptr, (bf16*)a.out, QW / 256, 0};
        pg8::gemm_phase<pg8::EpiB<1>, pg8::StaticOrder, GEMM_ALIGN, GEMM_SP2>(lds, g, S, E);
    }
    SEAM(2);
    if (IN(3)) REPS(3) { PH_ARGS(); PH_IDS(); attn_phase(a, lds, bid, G, tid); __syncthreads(); }
    SEAM(3);
    if (IN(4)) REPS(4) { PH_ARGS(); { PH_IDS();
        merge_rows(a, gw, NGW, lane); }
        pg8::Gemm g{(const bf16*)(ws + WS_U1), WIN + (size_t)3072 * DM, MT, ZW + GW - 768, DM}; pg8::StaticOrder S; S.init(MT, ZW + GW - 768, G, bid);
        pg8::EpiB<1> E{(bf16*)(ws + WS_ZHY), ZW, nullptr, (bf16*)a.out, ZW / 256, 768};
        pg8::gemm_phase<pg8::EpiB<1>, pg8::StaticOrder, GEMM_ALIGN, GEMM_SP2>(lds, g, S, E);
    }
    SEAM(4);
    if (IN(5)) REPS(5) { PH_ARGS(); PH_IDS(); hyena_prep(a, lds, bid, G, tid); filter_phase(a, lds, bid, G, tid); }
    SEAM(5);
    if (IN(6)) REPS(6) { PH_ARGS(); PH_IDS(); fftconv_phase(a, lds, bid, G, tid); }
    SEAM(6);
    if (IN(7)) REPS(7) { PH_ARGS(); PH_IDS(); hyena_gate(a, lds, bid, G, tid); }
    SEAM(7);
    if (IN(8)) REPS(8) { PH_ARGS();
        pg8::Gemm g{(const bf16*)(ws + WS_YH), WHB, MT, DM, DH}; pg8::StaticOrder S; S.init(MT, DM, G, bid);
        pg8::EpiB<2> E{(bf16*)(ws + WS_T1), DM, (const bf16*)a.out, nullptr, 0};
        pg8::gemm_phase<pg8::EpiB<2>, pg8::StaticOrder, GEMM_ALIGN, GEMM_SP2>(lds, g, S, E);
    }
    if (IN(9)) REPS(9) { PH_ARGS();
        pg8::Gemm g{(const bf16*)(ws + WS_YAT), WAB, MT, DM, 256}; pg8::StaticOrder S; S.init(MT, DM, G, bid);
        pg8::EpiB<3> E{(bf16*)(ws + WS_T1), DM, (const bf16*)a.out, nullptr, 0};
        pg8::gemm_phase<pg8::EpiB<3>, pg8::StaticOrder, GEMM_ALIGN, GEMM_SP2>(lds, g, S, E);
    }
    SEAM(9);
    if (IN(10)) REPS(10) { PH_ARGS();
        pg8::Gemm g{(const bf16*)(ws + WS_T1), WOUT, MT, DM, DM}; pg8::StaticOrder S; S.init(MT, DM, G, bid);
        pg8::EpiH E{a.in[I_XP], a.in[I_XS], (bf16*)(ws + WS_H16), MOD + 2048};
        pg8::gemm_phase<pg8::EpiH, pg8::StaticOrder, GEMM_ALIGN, GEMM_SP2>(lds, g, S, E);
    }
    SEAM(10);
    if (IN(11)) REPS(11) { PH_ARGS(); PH_IDS(); prep_rows<true, false>(nullptr, nullptr, (const bf16*)(ws + WS_H16), a.in[I_N2G], MOD, 3072, 4096, (bf16*)(ws + WS_U2), gw, NGW, lane); }
    SEAM(11);
#define MLP_HALF(kup, kdn, half) \
    if (IN(kup)) REPS(kup) { PH_ARGS(); \
        pg8::Gemm g{(const bf16*)(ws + WS_U2) + (size_t)(half) * (MT / 2) * DM, WUP, MT / 2, DFF, DM}; pg8::StaticOrder S; S.init(MT / 2, DFF, G, bid); \
        pg8::EpiB<5> E{(bf16*)(ws + WS_FF), DFF, nullptr, nullptr, 0}; \
        pg8::gemm_phase<pg8::EpiB<5>, pg8::StaticOrder, GEMM_ALIGN, GEMM_SP2>(lds, g, S, E); \
    } \
    SEAM(kup); \
    if (IN(kdn)) REPS(kdn) { PH_ARGS(); \
        pg8::Gemm g{(const bf16*)(ws + WS_FF), WDN, MT / 2, DM, DFF}; pg8::StaticOrder S; S.init(MT / 2, DM, G, bid); \
        pg8::EpiF E{(const bf16*)(ws + WS_H16), a.out, MOD + 5120, (half) * (MT / 2)}; \
        pg8::gemm_phase<pg8::EpiF, pg8::StaticOrder, GEMM_ALIGN, GEMM_SP2>(lds, g, S, E); \
    }
    MLP_HALF(12, 13, 0)
    SEAM(13);
    MLP_HALF(14, 15, 1)
}

extern "C" void kernel_launch(void* const* d_in, const int* in_sizes, int n_in, void* d_out, int out_size, void* d_ws, size_t ws_size, hipStream_t stream) {
    static int grid = 0;
    if (grid == 0) {
        if (n_in != 28 || in_sizes[0] != MP * DM || in_sizes[1] != MS * DM || out_size != MT * DM || ws_size < WS_END) {
            fprintf(stderr, "kernel_launch: unexpected shapes (n_in %d, in0 %d, out %d, ws %zu); nothing launched\n", n_in, n_in > 0 ? in_sizes[0] : -1, out_size, ws_size); grid = -1; return; }
        int dev = 0, cus = 0, per_cu = 0;
        if (hipGetDevice(&dev) != hipSuccess || hipDeviceGetAttribute(&cus, hipDeviceAttributeMultiprocessorCount, dev) != hipSuccess) { grid = -1; return; }
#if MK_PER_PHASE
        const void* fns[NPHASE] = {(const void*)mk_fwd<1>, (const void*)mk_fwd<2>, (const void*)mk_fwd<4>, (const void*)mk_fwd<8>, (const void*)mk_fwd<16>, (const void*)mk_fwd<32>, (const void*)mk_fwd<64>, (const void*)mk_fwd<128>,
                                   (const void*)mk_fwd<256>, (const void*)mk_fwd<512>, (const void*)mk_fwd<1024>, (const void*)mk_fwd<2048>, (const void*)mk_fwd<4096>, (const void*)mk_fwd<8192>, (const void*)mk_fwd<16384>, (const void*)mk_fwd<32768>};
        for (int p = 0; p < NPHASE; ++p) if (hipFuncSetAttribute(fns[p], hipFuncAttributeMaxDynamicSharedMemorySize, LDS_BYTES) != hipSuccess) { fprintf(stderr, "kernel_launch: hipFuncSetAttribute failed\n"); grid = -1; return; }
#else
        if (hipFuncSetAttribute((const void*)mk_fwd<0xffff>, hipFuncAttributeMaxDynamicSharedMemorySize, LDS_BYTES) != hipSuccess) { fprintf(stderr, "kernel_launch: hipFuncSetAttribute failed\n"); grid = -1; return; }
        if (hipOccupancyMaxActiveBlocksPerMultiprocessor(&per_cu, (const void*)mk_fwd<0xffff>, 512, LDS_BYTES) != hipSuccess || per_cu < 1) { fprintf(stderr, "kernel_launch: occupancy query says %d\n", per_cu); per_cu = 1; }
#endif
        (void)per_cu; (void)hipGetLastError();
        grid = cus * 1;
    }
    if (grid < 0) return;
    Args a{};
    for (int i = 0; i < 28; ++i) a.in[i] = (const float*)d_in[i];
    a.out = (float*)d_out; a.ws = (unsigned char*)d_ws;
#if MK_PER_PHASE
#ifndef HOST_REP_MASK
#define HOST_REP_MASK 0
#endif
#define LAUNCH_P(p) do { a.ph_lo = (p); a.ph_hi = (p) + 1; for (int r_ = 0; r_ < (((HOST_REP_MASK >> (p)) & 1) ? 2 : 1); ++r_) hipLaunchKernelGGL(mk_fwd<(1 << (p))>, dim3(grid), dim3(512), LDS_BYTES, stream, a); } while (0)
    LAUNCH_P(0); LAUNCH_P(1); LAUNCH_P(2); LAUNCH_P(3); LAUNCH_P(4); LAUNCH_P(5); LAUNCH_P(6); LAUNCH_P(7); LAUNCH_P(8); LAUNCH_P(9); LAUNCH_P(10); LAUNCH_P(11); LAUNCH_P(12); LAUNCH_P(13); LAUNCH_P(14); LAUNCH_P(15);
#else
    a.ph_lo = 0; a.ph_hi = NPHASE;
    if (hipMemsetAsync((char*)d_ws + WS_BAR, 0, XCD_BAR_WORDS * 4, stream) != hipSuccess) { fprintf(stderr, "kernel_launch: memset of the barrier words failed\n"); return; }
    void* args[] = {&a};
    hipError_t e = hipLaunchCooperativeKernel((const void*)mk_fwd<0xffff>, dim3(grid), dim3(512), args, LDS_BYTES, stream);
    if (e != hipSuccess) fprintf(stderr, "cooperative launch failed: %s (grid %d)\n", hipGetErrorString(e), grid);
#endif
}
```

```cpp
#include <hip/hip_runtime.h>
#include <hip/hip_cooperative_groups.h>
#include <cstdio>
#include <cstdint>
namespace cg = cooperative_groups;

#ifndef MK_PER_PHASE
#define MK_PER_PHASE 0
#endif

namespace pg8 {
#define PG8_LAS __attribute__((address_space(3)))
typedef unsigned short bf16_t;
typedef short bf16x8 __attribute__((ext_vector_type(8)));
typedef float f32x4 __attribute__((ext_vector_type(4)));
typedef unsigned u32x4 __attribute__((ext_vector_type(4)));
constexpr int BM = 256, BK = 64, HALF = 128, HTB = HALF * BK * 2  , STAGE_BYTES = 8 * HTB, NXCD = 8, WGM = 8;

__host__ __device__ __forceinline__ int lds_byte(int r, int c) { const int st = (r >> 4) * 2 + (c >> 5), rr = r & 15, cc = c & 31, ob = rr * 64 + cc * 2; return st * 1024 + (ob ^ (((ob >> 9) & 1) << 5)); }
__host__ __device__ __forceinline__ void stage_rc(int b, int& R, int& C) { const int st = b / 1024, sb = b % 1024, swz = sb ^ (((sb >> 9) & 1) << 5); R = (st >> 1) * 16 + swz / 64; C = (st & 1) * 32 + (swz % 64) / 2; }
__host__ __device__ __forceinline__ int perm32(int rho) { const int n = rho >> 4, i = rho & 15; return 8 * (i >> 2) + 4 * n + (i & 3); }

struct Unit { int pm, pn; };
struct Gemm { const bf16_t* A; const bf16_t* Bt; int M, N, K; };

struct StaticOrder {
    int nM, nN, nwg, G, c;
    __host__ __device__ void init(int M, int N, int G_, int c_) { nM = M / BM; nN = N / BM; nwg = nM * nN; G = G_; c = c_; }
    __host__ __device__ bool next(int i, Unit& u) const {
        const long L = (long)i * G + c; if (L >= nwg) return false;
        int wgid = (int)L; { const int q = nwg / NXCD, r = nwg % NXCD, xcd = wgid % NXCD, off = wgid / NXCD; wgid = (xcd < r ? xcd * (q + 1) : r * (q + 1) + (xcd - r) * q) + off; }
        const int nig = WGM * nN, gid = wgid / nig, fm = gid * WGM, gsz = (nM - fm) < WGM ? (nM - fm) : WGM;
        u.pm = fm + ((wgid % nig) % gsz); u.pn = (wgid % nig) / gsz; return true;
    }
    __device__ __forceinline__ void a_ready(const Unit&) const {}
    __device__ __forceinline__ void done(const Unit&) const {}
};

typedef float f32x2_t __attribute__((ext_vector_type(2))); typedef __bf16 bf16x2_t __attribute__((ext_vector_type(2)));
__device__ __forceinline__ unsigned cvt_pk_bf16(float lo, float hi) { f32x2_t v = {lo, hi}; bf16x2_t b = __builtin_convertvector(v, bf16x2_t); return __builtin_bit_cast(unsigned, b); }
__device__ __forceinline__ float bf_lo(unsigned w) { return __uint_as_float(w << 16); }
__device__ __forceinline__ float bf_hi(unsigned w) { return __uint_as_float(w & 0xffff0000u); }
__device__ __forceinline__ float sigmoidf_(float x) { return __builtin_amdgcn_rcpf(1.0f + __expf(-x)); }

constexpr int E_MP = 65536;

template <int MODE> struct EpiB {
    static constexpr bool PERM = true, AFTER_DRAIN = false;
    bf16_t* O; int ldc; const bf16_t* G; bf16_t* O2; int zsplit; int gcol0 = 0;
    __device__ __forceinline__ void operator()(const f32x4 (&acc)[2][2][4][2], const Unit& u, int wr, int wc, int fr, int fq) const {
        const int row0 = u.pm * BM + wr * 64 + fr; int colt = u.pn * BM; bf16_t* base = O; int ld = ldc; bool sig = false;
        if (MODE == 1) { if (u.pn >= zsplit) { base = O2; ld = 2048; colt += gcol0 - zsplit * BM; sig = true; } }
        const int col0 = colt + wc * 32 + 8 * fq;
        constexpr int MB = (MODE == 3) ? 2 : 4;
#pragma unroll
        for (int ai = 0; ai < 2; ++ai)
#pragma unroll
            for (int mb = 0; mb < 4; mb += MB) {
                typedef unsigned u32x2g __attribute__((ext_vector_type(2)));
                u32x2g gq[MB][2]; u32x4 tq[MODE == 3 ? MB : 1][2];
                if (MODE == 2 || MODE == 3) {
#pragma unroll
                    for (int mm = 0; mm < MB; ++mm)
#pragma unroll
                        for (int bj = 0; bj < 2; ++bj) { const size_t row = (size_t)(row0 + ai * HALF + (mb + mm) * 16);
                            gq[mm][bj] = *(const u32x2g*)((const unsigned char*)G + ((size_t)(u.pm * 8 + (MODE == 3 ? 4 : 0) + u.pn) << 16) + ((((ai * 4 + (mb + mm)) * 2 + bj) * 8 + (wr * 4 + wc)) << 9) + ((fq * 16 + fr) << 3));
                            if (MODE == 3) tq[mm][bj] = *(const u32x4*)(base + row * ld + col0 + bj * HALF); }
                }
#pragma unroll
                for (int mm = 0; mm < MB; ++mm) { const int m = mb + mm; const size_t row = (size_t)(row0 + ai * HALF + m * 16); bf16_t* rowp = base + row * ld + col0;
#pragma unroll
                    for (int bj = 0; bj < 2; ++bj) { f32x4 v0 = acc[ai][bj][m][0], v1 = acc[ai][bj][m][1];
                        if (MODE == 1) { if (sig) {
#pragma unroll
                            for (int j = 0; j < 4; ++j) { v0[j] = sigmoidf_(v0[j]); v1[j] = sigmoidf_(v1[j]); } } }
                        if (MODE == 2 || MODE == 3) {
                            const u32x2g g = gq[mm][bj]; const float k255 = 1.0f / 255.0f;
                            v0[0] *= (float)(g.x & 0xffu) * k255; v0[1] *= (float)((g.x >> 8) & 0xffu) * k255; v0[2] *= (float)((g.x >> 16) & 0xffu) * k255; v0[3] *= (float)(g.x >> 24) * k255;
                            v1[0] *= (float)(g.y & 0xffu) * k255; v1[1] *= (float)((g.y >> 8) & 0xffu) * k255; v1[2] *= (float)((g.y >> 16) & 0xffu) * k255; v1[3] *= (float)(g.y >> 24) * k255;
                            if (MODE == 3) { const u32x4 t = tq[mm][bj];
                                v0[0] += bf_lo(t.x); v0[1] += bf_hi(t.x); v0[2] += bf_lo(t.y); v0[3] += bf_hi(t.y);
                                v1[0] += bf_lo(t.z); v1[1] += bf_hi(t.z); v1[2] += bf_lo(t.w); v1[3] += bf_hi(t.w); }
                        }
                        if (MODE == 5) {
#pragma unroll
                            for (int j = 0; j < 4; ++j) { float a = fmaxf(v0[j], 0.f), b = fmaxf(v1[j], 0.f); v0[j] = a * a; v1[j] = b * b; } }
                        if (MODE == 1 && sig) {
                            typedef unsigned u32x2 __attribute__((ext_vector_type(2)));
                            unsigned lo = 0u, hv = 0u;
                            lo = __builtin_amdgcn_cvt_pk_u8_f32(v0[0] * 255.0f, 0, lo); lo = __builtin_amdgcn_cvt_pk_u8_f32(v0[1] * 255.0f, 1, lo); lo = __builtin_amdgcn_cvt_pk_u8_f32(v0[2] * 255.0f, 2, lo); lo = __builtin_amdgcn_cvt_pk_u8_f32(v0[3] * 255.0f, 3, lo);
                            hv = __builtin_amdgcn_cvt_pk_u8_f32(v1[0] * 255.0f, 0, hv); hv = __builtin_amdgcn_cvt_pk_u8_f32(v1[1] * 255.0f, 1, hv); hv = __builtin_amdgcn_cvt_pk_u8_f32(v1[2] * 255.0f, 2, hv); hv = __builtin_amdgcn_cvt_pk_u8_f32(v1[3] * 255.0f, 3, hv);
                            u32x2 w8; w8.x = lo; w8.y = hv;
                            const int gt_ = (gcol0 >> 8) + (u.pn - zsplit);
                            *(u32x2*)((unsigned char*)O2 + ((size_t)(u.pm * 8 + gt_) << 16) + ((((ai * 4 + m) * 2 + bj) * 8 + (wr * 4 + wc)) << 9) + ((fq * 16 + fr) << 3)) = w8;
                        } else {
                        u32x4 w; w.x = cvt_pk_bf16(v0[0], v0[1]); w.y = cvt_pk_bf16(v0[2], v0[3]); w.z = cvt_pk_bf16(v1[0], v1[1]); w.w = cvt_pk_bf16(v1[2], v1[3]);
                        *(u32x4*)(rowp + bj * HALF) = w; } } }
                if (MODE == 2 || MODE == 3) asm volatile("" ::: "memory");
            }
    }
};
struct EpiH {
    static constexpr bool PERM = true, AFTER_DRAIN = false;
    const float* xp; const float* xs; bf16_t* H; const float* gate;
    __device__ __forceinline__ void operator()(const f32x4 (&acc)[2][2][4][2], const Unit& u, int wr, int wc, int fr, int fq) const {
        const int rowt = u.pm * BM; const int modrow = rowt < E_MP ? (rowt >> 13) : 8 + ((rowt - E_MP) >> 12);
        const float* gt = gate + (size_t)modrow * 6144;
        const float* src = rowt < E_MP ? xp : xs - (size_t)E_MP * 1024;
        const int row0 = rowt + wr * 64 + fr, col0 = u.pn * BM + wc * 32 + 8 * fq;
        f32x4 gv[2][2];
#pragma unroll
        for (int bj = 0; bj < 2; ++bj)
#pragma unroll
            for (int n = 0; n < 2; ++n) gv[bj][n] = *(const f32x4*)(gt + col0 + bj * HALF + 4 * n);
#pragma unroll
        for (int ai = 0; ai < 2; ++ai)
#pragma unroll
            for (int mb = 0; mb < 4; mb += 2) {
                f32x4 sq[2][2][2];
#pragma unroll
                for (int mm = 0; mm < 2; ++mm)
#pragma unroll
                    for (int bj = 0; bj < 2; ++bj)
#pragma unroll
                        for (int n = 0; n < 2; ++n) sq[mm][bj][n] = *(const f32x4*)(src + (size_t)(row0 + ai * HALF + (mb + mm) * 16) * 1024 + col0 + bj * HALF + 4 * n);
#pragma unroll
                for (int mm = 0; mm < 2; ++mm)
#pragma unroll
                    for (int bj = 0; bj < 2; ++bj) { const f32x4 v0 = sq[mm][bj][0] + gv[bj][0] * acc[ai][bj][mb + mm][0], v1 = sq[mm][bj][1] + gv[bj][1] * acc[ai][bj][mb + mm][1];
                        u32x4 w; w.x = cvt_pk_bf16(v0[0], v0[1]); w.y = cvt_pk_bf16(v0[2], v0[3]); w.z = cvt_pk_bf16(v1[0], v1[1]); w.w = cvt_pk_bf16(v1[2], v1[3]);
                        *(u32x4*)(H + (size_t)(row0 + ai * HALF + (mb + mm) * 16) * 1024 + col0 + bj * HALF) = w; }
                asm volatile("" ::: "memory");
            }
    }
};
struct EpiF {
    static constexpr bool PERM = false, AFTER_DRAIN = false;
    const bf16_t* H; float* out; const float* gate; int row_off;
    __device__ __forceinline__ void operator()(const f32x4 (&acc)[2][2][4][2], const Unit& u, int wr, int wc, int fr, int fq) const {
        typedef unsigned u32x2 __attribute__((ext_vector_type(2)));
        const int rowt = row_off + u.pm * BM; const int modrow = rowt < E_MP ? (rowt >> 13) : 8 + ((rowt - E_MP) >> 12);
        const float* gt = gate + (size_t)modrow * 6144;
        const int row0 = rowt + wr * 64 + fr, col0 = u.pn * BM + wc * 32 + 4 * fq;
        f32x4 gv[2][2];
#pragma unroll
        for (int bj = 0; bj < 2; ++bj)
#pragma unroll
            for (int n = 0; n < 2; ++n) gv[bj][n] = *(const f32x4*)(gt + col0 + bj * HALF + n * 16);
#pragma unroll
        for (int ai = 0; ai < 2; ++ai) {
            u32x2 hq[4][2][2];
#pragma unroll
            for (int m = 0; m < 4; ++m)
#pragma unroll
                for (int bj = 0; bj < 2; ++bj)
#pragma unroll
                    for (int n = 0; n < 2; ++n) hq[m][bj][n] = *(const u32x2*)(H + (size_t)(row0 + ai * HALF + m * 16) * 1024 + col0 + bj * HALF + n * 16);
#pragma unroll
            for (int m = 0; m < 4; ++m)
#pragma unroll
                for (int bj = 0; bj < 2; ++bj)
#pragma unroll
                    for (int n = 0; n < 2; ++n) { const u32x2 h = hq[m][bj][n]; f32x4 hv; hv[0] = bf_lo(h.x); hv[1] = bf_hi(h.x); hv[2] = bf_lo(h.y); hv[3] = bf_hi(h.y);
                        *(f32x4*)(out + (size_t)(row0 + ai * HALF + m * 16) * 1024 + col0 + bj * HALF + n * 16) = hv + gv[bj][n] * acc[ai][bj][m][n]; }
            asm volatile("" ::: "memory");
        }
    }
};

template <class Epi, class Sched, bool ALIGN_EPI = false, bool SP2 = false>
__device__ __forceinline__ void gemm_phase(PG8_LAS unsigned char* lds, const Gemm g, const Sched& S, const Epi& E) {
    const int tid = threadIdx.x, wid = __builtin_amdgcn_readfirstlane(tid >> 6), lane = tid & 63, wr = wid >> 2, wc = wid & 3, fr = lane & 15, fq = lane >> 4;
    const int K = g.K, nt = K / BK;
    unsigned voffA[2], voffB[2];
#pragma unroll
    for (int i = 0; i < 2; ++i) { int R, C; stage_rc(tid * 16 + i * 8192, R, C); const int Rb = Epi::PERM ? ((R & ~31) + perm32(R & 31)) : R;
        voffA[i] = (unsigned)(R * K + C) * 2u; voffB[i] = (unsigned)(Rb * K + C) * 2u; }
    const size_t kstep = (size_t)(BK * 2);
    const size_t hstep = (size_t)HALF * K * 2;
    const size_t tstep = 2 * hstep;
    const unsigned ldsw = (unsigned)wid * 1024u;
    const int aoff = lds_byte(wr * 64 + fr, fq * 8), boff = lds_byte(wc * 32 + fr, fq * 8);
#define PG8_SA(b, h) (((b) * 2 + (h)) * HTB)
#define PG8_SB(b, h) ((4 + (b) * 2 + (h)) * HTB)
#define PG8_STAGE(bufoff, gbase, voff) do { _Pragma("unroll") for (int _i = 0; _i < 2; ++_i) \
        __builtin_amdgcn_global_load_lds((const unsigned*)((const char*)(gbase) + (voff)[_i]), (PG8_LAS unsigned*)(lds + (bufoff) + ldsw + _i * 8192), 16, 0, 0); } while (0)
#define PG8_LDA(dst, b, h) do { _Pragma("unroll") for (int m = 0; m < 4; ++m) _Pragma("unroll") for (int k = 0; k < 2; ++k) dst[m][k] = *(const PG8_LAS bf16x8*)(lds + PG8_SA(b, h) + aoff + m * 2048 + k * 1024); } while (0)
#define PG8_LDB(dst, b, h) do { _Pragma("unroll") for (int n = 0; n < 2; ++n) _Pragma("unroll") for (int k = 0; k < 2; ++k) dst[n][k] = *(const PG8_LAS bf16x8*)(lds + PG8_SB(b, h) + boff + n * 2048 + k * 1024); } while (0)
#define PG8_MMA(ai, bj, At, Bt) do { __builtin_amdgcn_s_setprio(1); _Pragma("unroll") for (int m = 0; m < 4; ++m) _Pragma("unroll") for (int n = 0; n < 2; ++n) _Pragma("unroll") for (int k = 0; k < 2; ++k) \
        acc[ai][bj][m][n] = __builtin_amdgcn_mfma_f32_16x16x32_bf16(Bt[n][k], At[m][k], acc[ai][bj][m][n], 0, 0, 0); __builtin_amdgcn_s_setprio(0); } while (0)
#define PG8_WAIT_V(n) asm volatile("s_waitcnt vmcnt(" #n ")" ::: "memory")
#define PG8_WAIT_L(n) asm volatile("s_waitcnt lgkmcnt(" #n ")" ::: "memory")
#define PG8_BAR __builtin_amdgcn_s_barrier()
#define PG8_SCHED __builtin_amdgcn_sched_barrier(0)
    Unit cur, nxt; int ui = 0;
    if (!S.next(0, cur)) return;
    f32x4 acc[2][2][4][2];
#pragma unroll
    for (int a = 0; a < 2; ++a)
#pragma unroll
        for (int b = 0; b < 2; ++b)
#pragma unroll
            for (int m = 0; m < 4; ++m)
#pragma unroll
                for (int n = 0; n < 2; ++n) acc[a][b][m][n] = (f32x4){0.f, 0.f, 0.f, 0.f};
    bf16x8 At[4][2], B0[2][2], B1[2][2];
    const char* cA = (const char*)g.A + (size_t)cur.pm * tstep; const char* cB = (const char*)g.Bt + (size_t)cur.pn * tstep;
    S.a_ready(cur);
    if constexpr (SP2) {
        PG8_STAGE(PG8_SB(0, 0), cB, voffB); PG8_STAGE(PG8_SB(0, 1), cB + hstep, voffB); PG8_STAGE(PG8_SA(0, 0), cA, voffA); PG8_STAGE(PG8_SA(0, 1), cA + hstep, voffA);
        if (wr == 1) PG8_BAR;
        PG8_WAIT_V(2); PG8_BAR;
        PG8_STAGE(PG8_SB(1, 0), cB + kstep, voffB); PG8_STAGE(PG8_SA(1, 0), cA + kstep, voffA); PG8_STAGE(PG8_SB(1, 1), cB + hstep + kstep, voffB);
        PG8_WAIT_V(6); PG8_BAR;
    } else {
        PG8_STAGE(PG8_SB(0, 0), cB, voffB); PG8_STAGE(PG8_SA(0, 0), cA, voffA); PG8_STAGE(PG8_SB(0, 1), cB + hstep, voffB); PG8_STAGE(PG8_SA(0, 1), cA + hstep, voffA);
        if (wr == 1) PG8_BAR;
        PG8_WAIT_V(4); PG8_BAR;
        PG8_STAGE(PG8_SB(1, 0), cB + kstep, voffB); PG8_STAGE(PG8_SA(1, 0), cA + kstep, voffA); PG8_STAGE(PG8_SB(1, 1), cB + hstep + kstep, voffB);
        PG8_WAIT_V(6); PG8_BAR;
    }
    for (;;) {
        const bool has_next = S.next(ui + 1, nxt);
        const char* nA = has_next ? (const char*)g.A + (size_t)nxt.pm * tstep : cA; const char* nB = has_next ? (const char*)g.Bt + (size_t)nxt.pn * tstep : cB;
        for (int t = 0; t < nt; t += 2) {
            const bool last = (t == nt - 2);
            const char* a1 = cA + (size_t)(t + 1) * kstep;
            const char* a2 = last ? nA : cA + (size_t)(t + 2) * kstep; const char* b2 = last ? nB : cB + (size_t)(t + 2) * kstep;
            const char* a3 = a2 + kstep; const char* b3 = b2 + kstep;
            if (last && has_next) S.a_ready(nxt);
            if constexpr (SP2) {
            PG8_LDB(B0, 0, 0); PG8_LDB(B1, 0, 1); PG8_SCHED; PG8_LDA(At, 0, 0); PG8_STAGE(PG8_SA(1, 1), a1 + hstep, voffA);
            PG8_WAIT_V(8); PG8_WAIT_L(0); PG8_BAR; PG8_MMA(0, 0, At, B0); PG8_MMA(0, 1, At, B1); PG8_BAR; PG8_SCHED;
            PG8_LDA(At, 0, 1); PG8_STAGE(PG8_SB(0, 0), b2, voffB); PG8_STAGE(PG8_SB(0, 1), b2 + hstep, voffB); PG8_STAGE(PG8_SA(0, 0), a2, voffA);
            PG8_WAIT_V(8); PG8_WAIT_L(0); PG8_BAR; PG8_MMA(1, 0, At, B0); PG8_MMA(1, 1, At, B1); PG8_BAR; PG8_SCHED;
            PG8_LDB(B0, 1, 0); PG8_LDB(B1, 1, 1); PG8_SCHED; PG8_LDA(At, 1, 0); PG8_STAGE(PG8_SA(0, 1), a2 + hstep, voffA);
            PG8_WAIT_V(8); PG8_WAIT_L(0); PG8_BAR; PG8_MMA(0, 0, At, B0); PG8_MMA(0, 1, At, B1); PG8_BAR; PG8_SCHED;
            PG8_LDA(At, 1, 1); PG8_STAGE(PG8_SB(1, 0), b3, voffB); PG8_STAGE(PG8_SB(1, 1), b3 + hstep, voffB); PG8_STAGE(PG8_SA(1, 0), a3, voffA);
            PG8_WAIT_V(8); PG8_WAIT_L(0); PG8_BAR; PG8_MMA(1, 0, At, B0); PG8_MMA(1, 1, At, B1); PG8_BAR; PG8_SCHED;
            } else {
            PG8_LDB(B0, 0, 0); PG8_SCHED; PG8_LDA(At, 0, 0); PG8_STAGE(PG8_SA(1, 1), a1 + hstep, voffA);
            PG8_WAIT_L(8); PG8_BAR; PG8_WAIT_L(0); PG8_MMA(0, 0, At, B0); PG8_BAR; PG8_SCHED;
            PG8_LDB(B1, 0, 1); PG8_STAGE(PG8_SB(0, 0), b2, voffB);
            PG8_BAR; PG8_WAIT_L(0); PG8_MMA(0, 1, At, B1); PG8_BAR;
            PG8_LDA(At, 0, 1); PG8_STAGE(PG8_SA(0, 0), a2, voffA);
            PG8_BAR; PG8_WAIT_L(0); PG8_MMA(1, 0, At, B0); PG8_BAR; PG8_SCHED;
            PG8_STAGE(PG8_SB(0, 1), b2 + hstep, voffB);
            PG8_WAIT_V(6); PG8_BAR; PG8_MMA(1, 1, At, B1); PG8_BAR;
            PG8_LDB(B0, 1, 0); PG8_SCHED; PG8_LDA(At, 1, 0); PG8_STAGE(PG8_SA(0, 1), a2 + hstep, voffA);
            PG8_WAIT_L(8); PG8_BAR; PG8_WAIT_L(0); PG8_MMA(0, 0, At, B0); PG8_BAR; PG8_SCHED;
            PG8_LDB(B1, 1, 1); PG8_STAGE(PG8_SB(1, 0), b3, voffB);
            PG8_BAR; PG8_WAIT_L(0); PG8_MMA(0, 1, At, B1); PG8_BAR;
            PG8_LDA(At, 1, 1); PG8_STAGE(PG8_SA(1, 0), a3, voffA);
            PG8_BAR; PG8_WAIT_L(0); PG8_MMA(1, 0, At, B0); PG8_BAR; PG8_SCHED;
            PG8_STAGE(PG8_SB(1, 1), b3 + hstep, voffB);
            PG8_WAIT_V(6); PG8_BAR; PG8_MMA(1, 1, At, B1); PG8_BAR;
            }
        }
        if constexpr (ALIGN_EPI) { if (wr == 0) PG8_BAR; }
        if constexpr (!Epi::AFTER_DRAIN) { E(acc, cur, wr, wc, fr, fq); S.done(cur); }
        if (!has_next) break;
#pragma unroll
        for (int a = 0; a < 2; ++a)
#pragma unroll
            for (int b = 0; b < 2; ++b)
#pragma unroll
                for (int m = 0; m < 4; ++m)
#pragma unroll
                    for (int n = 0; n < 2; ++n) acc[a][b][m][n] = (f32x4){0.f, 0.f, 0.f, 0.f};
        cur = nxt; cA = nA; cB = nB; ++ui;
        if constexpr (ALIGN_EPI) { if (wr == 1) PG8_BAR; }
    }
    PG8_WAIT_V(0);
    if constexpr (!ALIGN_EPI) { if (wr == 0) PG8_BAR; }
    PG8_BAR;
    if constexpr (Epi::AFTER_DRAIN) { E.fused(acc, cur, wr, wc, fr, fq, lds, wid, lane); S.done(cur); }
#undef PG8_SA
#undef PG8_SB
#undef PG8_STAGE
#undef PG8_LDA
#undef PG8_LDB
#undef PG8_MMA
#undef PG8_WAIT_V
#undef PG8_WAIT_L
#undef PG8_BAR
#undef PG8_SCHED
}
}

constexpr int DM = 1024, LP = 8192, LS = 4096, NB = 8;
constexpr int MP = NB * LP, MS = NB * LS, MT = MP + MS;
constexpr int DH = 768, ZW = 2304, QW = 2304, GW = 2048, DFF = 4096, NIN = 6656;
constexpr float RMS_EPS = 1e-6f;
static_assert(MP == pg8::E_MP, "row split");
constexpr size_t MiB = 1u << 20;
constexpr size_t WS_MOD = 0, WS_H3 = 1 * MiB, WS_BAR = 4 * MiB;
constexpr size_t WS_WIN = 8 * MiB, WS_WHB = 21 * MiB, WS_WAB = 23 * MiB, WS_WOUT = 24 * MiB, WS_WUP = 26 * MiB, WS_WDN = 34 * MiB;
constexpr size_t WS_U1 = 48 * MiB, WS_KSPEC = 48 * MiB, WS_T1 = 48 * MiB;
constexpr size_t WS_H16 = 240 * MiB, WS_FF = 432 * MiB;
constexpr size_t WS_QKV = 240 * MiB, WS_ZHY = 240 * MiB;
constexpr size_t WS_OG = 672 * MiB, WS_UCT = 672 * MiB;
constexpr size_t WS_LSE = 816 * MiB, WS_YH = 816 * MiB, WS_U2 = 816 * MiB;
constexpr size_t WS_YAT = 960 * MiB, WS_END = 1008 * MiB;
constexpr size_t WS_KRAW = 880 * MiB;
constexpr int LDS_BYTES = 147456;
constexpr int NPHASE = 16;

#define LAS __attribute__((address_space(3)))
typedef unsigned short bf16;
typedef unsigned v4u __attribute__((ext_vector_type(4)));
typedef unsigned v2u __attribute__((ext_vector_type(2)));
typedef float f32x4 __attribute__((ext_vector_type(4)));
typedef short bf16x8 __attribute__((ext_vector_type(8)));
typedef float f32x16 __attribute__((ext_vector_type(16)));
#define LDS_WAIT() asm volatile("s_waitcnt lgkmcnt(0)" ::: "memory")
__device__ __forceinline__ float bf2f(unsigned short h) { return __uint_as_float((unsigned)h << 16); }
__device__ __forceinline__ unsigned pk2(float lo, float hi) { return pg8::cvt_pk_bf16(lo, hi); }
__device__ __forceinline__ float wave_sum(float v) {
#pragma unroll
    for (int o = 1; o < 64; o <<= 1) v += __shfl_xor(v, o);
    return v;
}

#define FFT_DI __device__ __forceinline__
#define FFT_ASM 1
#define FFT_SINCOSPI(x, s, c) do { const float h_ = 0.5f * (x); (s) = __builtin_amdgcn_sinf(h_); (c) = __builtin_amdgcn_cosf(h_); } while (0)
__device__ __forceinline__ int lnd(int x) { asm volatile("" : "+v"(x)); return x; }
#define FFT_LND(x) lnd(x)
#define FFT_SCHED() __builtin_amdgcn_sched_barrier(0)
#ifndef GEMM_SP2
#define GEMM_SP2 true
#endif
#define FFT_TRANS_FENCE(a, b) asm volatile("s_nop 1" : "+v"(a), "+v"(b))
#ifndef GEMM_ALIGN
#define GEMM_ALIGN true
#endif
typedef float cf2 __attribute__((ext_vector_type(2)));
#ifdef FFT_ASM
FFT_DI cf2 cmul_conjw(cf2 d, cf2 W) { cf2 t, o; asm("v_pk_mul_f32 %0, %1, %2 op_sel_hi:[1,0]" : "=v"(t) : "v"(d), "v"(W));
    asm("v_pk_fma_f32 %0, %1, %2, %3 op_sel:[1,1,0] op_sel_hi:[0,1,1] neg_hi:[1,0,0]" : "=v"(o) : "v"(d), "v"(W), "v"(t)); return o; }
FFT_DI cf2 cmul_w(cf2 b, cf2 W) { cf2 t, o; asm("v_pk_mul_f32 %0, %1, %2 op_sel_hi:[1,0]" : "=v"(t) : "v"(b), "v"(W));
    asm("v_pk_fma_f32 %0, %1, %2, %3 op_sel:[1,1,0] op_sel_hi:[0,1,1] neg_lo:[1,0,0]" : "=v"(o) : "v"(b), "v"(W), "v"(t)); return o; }
#else
FFT_DI cf2 cmul_conjw(cf2 d, cf2 W) { cf2 dr; dr.x = d.y; dr.y = -d.x; return d * __builtin_shufflevector(W, W, 0, 0) + dr * __builtin_shufflevector(W, W, 1, 1); }
FFT_DI cf2 cmul_w(cf2 b, cf2 W) { cf2 br; br.x = -b.y; br.y = b.x; return b * __builtin_shufflevector(W, W, 0, 0) + br * __builtin_shufflevector(W, W, 1, 1); }
#endif
FFT_DI cf2 cmul(cf2 a, cf2 b) { return cmul_w(a, b); }
#define FFT_C32(j) ((j) == 0 ? 1.0f : (j) == 1 ? 0.98078528040323043f : (j) == 2 ? 0.92387953251128674f : (j) == 3 ? 0.83146961230254524f : (j) == 4 ? 0.70710678118654752f : (j) == 5 ? 0.55557023301960218f : (j) == 6 ? 0.38268343236508977f : (j) == 7 ? 0.19509032201612825f : (j) == 8 ? 0.0f : (j) == 9 ? -0.19509032201612825f : (j) == 10 ? -0.38268343236508977f : (j) == 11 ? -0.55557023301960218f : (j) == 12 ? -0.70710678118654752f : (j) == 13 ? -0.83146961230254524f : (j) == 14 ? -0.92387953251128674f : -0.98078528040323043f)
FFT_DI constexpr float fft_cos32(int j) { return FFT_C32(j); }
FFT_DI constexpr float fft_sin32(int j) { return FFT_C32((j) >= 8 ? (j) - 8 : 8 - (j)); }

template <int Q, bool Z>
FFT_DI void fft_twiddles(cf2 (&Wm)[16], int i0low, int slog) {
    constexpr int q = Q;
    if (Z) {
#pragma unroll
        for (int m = 0; m < (1 << q); ++m) { Wm[m].x = fft_cos32(m << (4 - q)); Wm[m].y = fft_sin32(m << (4 - q)); }
    } else {
        float sb, cb; FFT_SINCOSPI((float)FFT_LND(i0low) * (1.0f / (float)(1 << (slog + q))), sb, cb);
        FFT_TRANS_FENCE(sb, cb);
        Wm[0].x = cb; Wm[0].y = sb;
        cf2 R; R.x = fft_cos32(1 << (4 - q)); R.y = fft_sin32(1 << (4 - q));
#pragma unroll
        for (int m = 1; m < (1 << q); ++m) Wm[m] = cmul_w(Wm[m - 1], R);
    }
}
template <int K, int OFF, int Q, bool Z>
FFT_DI void dif_stage(cf2 (&v)[32], int i0low, int slog) {
    constexpr int q = Q;
    cf2 Wm[16]; fft_twiddles<Q, Z>(Wm, i0low, slog);
#pragma unroll
    for (int e = 0; e < (1 << K); ++e) if (!(e & (1 << q))) {
        const int m = e & ((1 << q) - 1);
        const cf2 a = v[OFF + e], b = v[OFF + e + (1 << q)];
        v[OFF + e] = a + b;
        const cf2 d = a - b;
        if (Z && m == 0) v[OFF + e + (1 << q)] = d; else v[OFF + e + (1 << q)] = cmul_conjw(d, Wm[m]);
    }
}
template <int K, int OFF, bool Z = false>
FFT_DI void dif_stages(cf2 (&v)[32], int i0low, int slog) {
    if constexpr (K >= 5) dif_stage<K, OFF, 4, Z>(v, i0low, slog);
    dif_stage<K, OFF, 3, Z>(v, i0low, slog); dif_stage<K, OFF, 2, Z>(v, i0low, slog); dif_stage<K, OFF, 1, Z>(v, i0low, slog); dif_stage<K, OFF, 0, Z>(v, i0low, slog);
}
template <int K, int OFF, int Q, bool Z>
FFT_DI void dit_stage(cf2 (&v)[32], int i0low, int slog) {
    constexpr int q = Q;
    cf2 Wm[16]; fft_twiddles<Q, Z>(Wm, i0low, slog);
#pragma unroll
    for (int e = 0; e < (1 << K); ++e) if (!(e & (1 << q))) {
        const int m = e & ((1 << q) - 1);
        const cf2 a = v[OFF + e], b0 = v[OFF + e + (1 << q)];
        cf2 bw; if (Z && m == 0) bw = b0; else bw = cmul_w(b0, Wm[m]);
        v[OFF + e] = a + bw; v[OFF + e + (1 << q)] = a - bw;
    }
}
template <int K, int OFF, bool Z = false>
FFT_DI void dit_stages(cf2 (&v)[32], int i0low, int slog) {
    dit_stage<K, OFF, 0, Z>(v, i0low, slog); dit_stage<K, OFF, 1, Z>(v, i0low, slog); dit_stage<K, OFF, 2, Z>(v, i0low, slog); dit_stage<K, OFF, 3, Z>(v, i0low, slog);
    if constexpr (K >= 5) dit_stage<K, OFF, 4, Z>(v, i0low, slog);
}
FFT_DI int fft_swz(int i) { return i ^ ((i >> 5) & 31); }
FFT_DI int fft_idxA(int tid, int e) { return tid + 512 * e; }
FFT_DI int fft_idxB(int tid, int e) { return ((tid >> 4) << 9) + (tid & 15) + 16 * e; }
FFT_DI int fft_idxC(int tid, int e) { return 32 * tid + e; }

struct Args { const float* in[28]; float* out; unsigned char* ws; int ph_lo, ph_hi; };
enum { I_XP = 0, I_XS, I_CP, I_CS, I_RELB, I_ADAW, I_ADAB, I_N1G, I_WIN, I_CONVW, I_CONVB, I_FW1, I_FB1, I_FW2, I_FB2, I_FW3, I_FB3, I_FFREQ, I_FWOUT,
       I_HYD, I_QNG, I_KNG, I_WHB, I_WAB, I_WOUT, I_N2G, I_WUP, I_WDN };

__device__ __forceinline__ void p0_transpose_item(const float* W, int K, int N, bf16* WT, int row_off, LAS float* scr, int item, int lane) {
    const int nblk = N / 32, kb = item / nblk, nb = item % nblk, k0 = 64 * kb, n0 = 32 * nb;
#pragma unroll 8
    for (int i = 0; i < 32; ++i) { const int kk = 2 * i + (lane >> 5); scr[kk * 33 + (lane & 31)] = W[(size_t)(k0 + kk) * N + n0 + (lane & 31)]; }
    LDS_WAIT();
    const int c = lane & 7;
#pragma unroll
    for (int j = 0; j < 4; ++j) { const int n = (lane >> 3) + 8 * j; const LAS float* s = scr + (8 * c) * 33 + n;
        v4u o; o.x = pk2(s[0 * 33], s[1 * 33]); o.y = pk2(s[2 * 33], s[3 * 33]); o.z = pk2(s[4 * 33], s[5 * 33]); o.w = pk2(s[6 * 33], s[7 * 33]);
        *(v4u*)(WT + (size_t)(row_off + n0 + n) * K + k0 + 8 * c) = o; }
    LDS_WAIT();
}

__device__ __forceinline__ void p0_mod(const Args& a, LAS unsigned char* lds, int bid, int G, int tid) {
    LAS float* S = (LAS float*)lds;
    LAS float* P = (LAS float*)(lds + 65536);
    const int wave = tid >> 6, lane = tid & 63;
    float* MOD = (float*)(a.ws + WS_MOD);
    for (int cb = bid; cb < 96; cb += G) {
        for (int idx = tid; idx < 16384; idx += 512) { const int r = idx >> 10, k = idx & 1023;
            const float c = r < 8 ? a.in[I_CP][r * 1024 + k] : a.in[I_CS][(r - 8) * 1024 + k];
            S[k * 16 + r] = c / (1.0f + __expf(-c)); }
        __syncthreads();
        float acc[16];
#pragma unroll
        for (int r = 0; r < 16; ++r) acc[r] = 0.f;
        const float* wp = a.in[I_ADAW] + cb * 64 + lane;
#pragma unroll 4
        for (int k = wave * 128; k < wave * 128 + 128; ++k) {
            const float wv = wp[(size_t)k * 6144];
#pragma unroll
            for (int r4 = 0; r4 < 4; ++r4) { const f32x4 s = *(const LAS f32x4*)(S + k * 16 + r4 * 4);
                acc[r4 * 4 + 0] += s.x * wv; acc[r4 * 4 + 1] += s.y * wv; acc[r4 * 4 + 2] += s.z * wv; acc[r4 * 4 + 3] += s.w * wv; }
        }
#pragma unroll
        for (int r = 0; r < 16; ++r) P[(wave * 16 + r) * 64 + lane] = acc[r];
        __syncthreads();
        for (int o = tid; o < 1024; o += 512) { const int r = o >> 6, col = o & 63; float s = a.in[I_ADAB][cb * 64 + col];
#pragma unroll
            for (int w = 0; w < 8; ++w) s += P[(w * 16 + r) * 64 + col];
            MOD[r * 6144 + cb * 64 + col] = s; }
        __syncthreads();
    }
}

__device__ __forceinline__ void p0_h3(const Args& a, int gw, int NGW, int lane) {
    float* H3 = (float*)(a.ws + WS_H3);
    const float fr = a.in[I_FFREQ][lane];
    const float b1 = a.in[I_FB1][lane], b2 = a.in[I_FB2][lane], b3 = a.in[I_FB3][lane];
    for (int p = gw; p < LP + LS; p += NGW) {
        const int grp = p >= LP, t = p - grp * LP, L = grp ? LS : LP;
        const float tt = (float)t * (1.0f / (float)(L - 1));
        const float w = 6.2831853071795864769f * (float)t / (float)L;
        float feat = 0.f;
        if (lane == 0) feat = tt;
        else if (lane <= 32) { const int bi = (lane - 1) & 15; const float band = 1e-4f + (float)bi * ((15.0f - 1e-4f) / 15.0f); const float ang = band * w;
            feat = lane <= 16 ? cosf(ang) : -sinf(ang); }
        float acc = b1;
        for (int i = 0; i < 33; ++i) acc += __shfl(feat, i) * a.in[I_FW1][i * 64 + lane];
        float h = sinf(fr * acc);
        acc = b2;
        for (int i = 0; i < 64; ++i) acc += __shfl(h, i) * a.in[I_FW2][i * 64 + lane];
        h = sinf(fr * acc);
        acc = b3;
        for (int i = 0; i < 64; ++i) acc += __shfl(h, i) * a.in[I_FW3][i * 64 + lane];
        h = sinf(fr * acc);
        H3[(size_t)p * 64 + lane] = h;
    }
}

template <bool BF> __device__ __forceinline__ void prep_rows(const float* xp, const float* xs, const bf16* hb, const float* g, const float* MOD, int shoff, int scoff, bf16* U, int gw, int NGW, int lane) {
    constexpr int R = 4;
    for (int mb = gw; mb < MT; mb += R * NGW) {
        f32x4 v[R][4]; float s[R];
#pragma unroll
        for (int r = 0; r < R; ++r) { const int m = mb + r * NGW; const int mc = m < MT ? m : mb;
#pragma unroll
            for (int j = 0; j < 4; ++j) {
                if (BF) { const v2u a0 = *(const v2u*)(hb + (size_t)mc * DM + 4 * lane + 256 * j);
                    v[r][j].x = pg8::bf_lo(a0.x); v[r][j].y = pg8::bf_hi(a0.x); v[r][j].z = pg8::bf_lo(a0.y); v[r][j].w = pg8::bf_hi(a0.y); }
                else { const float* xr = mc < MP ? xp + (size_t)mc * DM : xs + (size_t)(mc - MP) * DM; v[r][j] = *(const f32x4*)(xr + 4 * lane + 256 * j); } } }
#pragma unroll
        for (int r = 0; r < R; ++r) { float t = 0.f;
#pragma unroll
            for (int j = 0; j < 4; ++j) t += (v[r][j].x * v[r][j].x + v[r][j].y * v[r][j].y) + (v[r][j].z * v[r][j].z + v[r][j].w * v[r][j].w);
            s[r] = t; }
#pragma unroll
        for (int o = 1; o < 64; o <<= 1) {
#pragma unroll
            for (int r = 0; r < R; ++r) s[r] += __shfl_xor(s[r], o); }
#pragma unroll
        for (int r = 0; r < R; ++r) { const int m = mb + r * NGW; if (m < MT) {
            const float rstd = 1.0f / sqrtf(s[r] * (1.0f / DM) + RMS_EPS);
            const float* mr = MOD + (size_t)(m < MP ? (m >> 13) : 8 + ((m - MP) >> 12)) * 6144;
#pragma unroll
            for (int j = 0; j < 4; ++j) { const int c = 4 * lane + 256 * j;
                const f32x4 gg = *(const f32x4*)(g + c), sc = *(const f32x4*)(mr + scoff + c), sh = *(const f32x4*)(mr + shoff + c);
                const f32x4 o = v[r][j] * rstd * gg * (sc + 1.0f) + sh; v2u w; w.x = pk2(o.x, o.y); w.y = pk2(o.z, o.w); *(v2u*)(U + (size_t)m * DM + c) = w; } } }
    }
}

#define MFMA32(a, b, c) __builtin_amdgcn_mfma_f32_32x32x16_bf16((a), (b), (c), 0, 0, 0)
__device__ __forceinline__ int crow(int r, int hi) { return (r & 3) + 8 * (r >> 2) + 4 * hi; }
__device__ __forceinline__ int t5_bucket_dev(int rel) {
    const int n = rel < 0 ? -rel : rel; const int ret = rel > 0 ? 16 : 0;
    int large = 8 + (int)(logf((float)(n > 1 ? n : 1) / 8.0f) / 4.852030263919617f * 8.0f);
    large = large < 15 ? large : 15;
    return ret + (n < 8 ? n : large);
}
__device__ __forceinline__ void load_raw(const bf16* p, v4u (&raw)[4]) {
#pragma unroll
    for (int kk = 0; kk < 4; ++kk) raw[kk] = *(const v4u*)(p + 16 * kk);
}
__device__ __forceinline__ void norm_frag(const v4u (&raw)[4], const float* gain, float mul, int hi, bool valid, bf16x8 (&f)[4]) {
    float ss = 0.f;
#pragma unroll
    for (int kk = 0; kk < 4; ++kk)
#pragma unroll
        for (int w = 0; w < 4; ++w) { const unsigned u = raw[kk][w]; const float lo = pg8::bf_lo(u), hv = pg8::bf_hi(u); ss += lo * lo + hv * hv; }
    ss += __shfl_xor(ss, 32);
    const float rstd = (valid ? mul : 0.f) / sqrtf(ss * (1.0f / 64.0f) + RMS_EPS);
#pragma unroll
    for (int kk = 0; kk < 4; ++kk) { const f32x4 g0 = *(const f32x4*)(gain + 8 * hi + 16 * kk) * rstd, g1 = *(const f32x4*)(gain + 8 * hi + 16 * kk + 4) * rstd;
        const v4u r4 = raw[kk];
        v4u o; o.x = pk2(pg8::bf_lo(r4.x) * g0.x, pg8::bf_hi(r4.x) * g0.y); o.y = pk2(pg8::bf_lo(r4.y) * g0.z, pg8::bf_hi(r4.y) * g0.w);
        o.z = pk2(pg8::bf_lo(r4.z) * g1.x, pg8::bf_hi(r4.z) * g1.y); o.w = pk2(pg8::bf_lo(r4.w) * g1.z, pg8::bf_hi(r4.w) * g1.w);
        f[kk] = __builtin_bit_cast(bf16x8, o); }
}
typedef short v4i16_t __attribute__((ext_vector_type(4)));
constexpr int ATT_PITCH = 144;
constexpr int ATT_BTW = 192;
constexpr int ATT_KOFF = 12 * ATT_BTW * 4, ATT_VOFF = ATT_KOFF + 384 * ATT_PITCH;
__device__ __forceinline__ void attn_phase(const Args& a, LAS unsigned char* lds, int bid, int G, int tid) {
    const int wave = tid >> 6, lane = tid & 63, ql = lane & 31, hi = lane >> 5;
    LAS float* BT = (LAS float*)lds;
    LAS unsigned char* Ks = lds + ATT_KOFF; LAS unsigned char* Vs = lds + ATT_VOFF;
    for (int idx = tid; idx < 12 * ATT_BTW; idx += 512) { const int h = idx / ATT_BTW, rel = idx % ATT_BTW - 95, g = h >> 2;
        BT[idx] = (rel >= -64 && rel <= 64) ? a.in[I_RELB][t5_bucket_dev(rel << (2 * g)) * 12 + h] * 1.4426950408889634f : -1.0e30f; }
    __syncthreads();
    const bf16* QKV = (const bf16*)(a.ws + WS_QKV);
    bf16* OG = (bf16*)(a.ws + WS_OG); float* LSE = (float*)(a.ws + WS_LSE);
    const int i16 = lane & 15, trq = i16 >> 2, trp = i16 & 3, blk = (lane >> 4) & 1;
    const int troff = (32 * wave + 4 * hi + trq) * ATT_PITCH + (16 * blk) * 2 + 8 * trp;
    const int srow = tid >> 3, sch = tid & 7;
#define ATT_DECODE(u_, rowbase_, h_, r_, Q0_, S_, dlog_) do { int grp_, bh_, w_, L_; \
        if ((u_) < 3072) { grp_ = 0; bh_ = (u_) >> 5; w_ = (u_) & 31; L_ = LP; } else { grp_ = 1; const int r2_ = (u_) - 3072; bh_ = r2_ >> 4; w_ = r2_ & 15; L_ = LS; } \
        const int b_ = bh_ / 12; h_ = bh_ % 12; dlog_ = 2 * (h_ >> 2); S_ = L_ >> dlog_; const int upr_ = S_ >> 8; r_ = w_ / upr_; Q0_ = (w_ % upr_) * 256; \
        rowbase_ = grp_ ? MP + b_ * LS : b_ * LP; } while (0)
#define ATT_LOADKV(rowbase_, h_, r_, Q0_, S_, dlog_, KLO, VLO, VHI) do { _Pragma("unroll") for (int p = 0; p < 6; ++p) { int sk = (Q0_) - 64 + 64 * p + srow; sk = sk < 0 ? 0 : (sk >= (S_) ? (S_) - 1 : sk); \
        const bf16* rp = QKV + ((size_t)(rowbase_) + ((size_t)sk << (dlog_)) + (r_)) * QW + (h_) * 64 + sch * 8; if (p >= (KLO)) kr[p] = *(const v4u*)(rp + 768); if (p >= (VLO) && p < (VHI)) vr[p] = *(const v4u*)(rp + 1536); } } while (0)
    v4u kr[6], vr[6], qr[4];
#define ATT_LOADQ(rowbase_, h_, r_, Q0_, dlog_) load_raw(QKV + ((size_t)(rowbase_) + ((size_t)((Q0_) + 32 * wave + ql) << (dlog_)) + (r_)) * QW + (h_) * 64 + 8 * hi, qr)
    const int avid = (G % 8 == 0) ? (bid >> 3) + (G >> 3) * (bid & 7) : bid;
    if (avid < 4608) { int rb, h, r, Q0, S, dlog; ATT_DECODE(avid, rb, h, r, Q0, S, dlog); ATT_LOADKV(rb, h, r, Q0, S, dlog, 0, 0, 6); ATT_LOADQ(rb, h, r, Q0, dlog); }
    for (int u = avid; u < 4608; u += G) {
        int rowbase, h, r, Q0, S, dlog; ATT_DECODE(u, rowbase, h, r, Q0, S, dlog);
        const int g = h >> 2, hh = h & 3, K0 = Q0 - 64;

        { const f32x4 g0 = *(const f32x4*)(a.in[I_KNG] + h * 64 + sch * 8), g1 = *(const f32x4*)(a.in[I_KNG] + h * 64 + sch * 8 + 4);
#pragma unroll
          for (int p = 0; p < 6; ++p) { const int kl = 64 * p + srow, sk = K0 + kl; const bool valid = sk >= 0 && sk < S;
              const v4u r4 = kr[p]; float ss = 0.f;
#pragma unroll
              for (int w4 = 0; w4 < 4; ++w4) { const float lo = pg8::bf_lo(r4[w4]), hv = pg8::bf_hi(r4[w4]); ss += lo * lo + hv * hv; }
              ss += __shfl_xor(ss, 1); ss += __shfl_xor(ss, 2); ss += __shfl_xor(ss, 4);
              const float rstd = valid ? 1.0f / sqrtf(ss * (1.0f / 64.0f) + RMS_EPS) : 0.f;
              v4u o; o.x = pk2(pg8::bf_lo(r4.x) * rstd * g0.x, pg8::bf_hi(r4.x) * rstd * g0.y); o.y = pk2(pg8::bf_lo(r4.y) * rstd * g0.z, pg8::bf_hi(r4.y) * rstd * g0.w);
              o.z = pk2(pg8::bf_lo(r4.z) * rstd * g1.x, pg8::bf_hi(r4.z) * rstd * g1.y); o.w = pk2(pg8::bf_lo(r4.w) * rstd * g1.z, pg8::bf_hi(r4.w) * rstd * g1.w);
              *(LAS v4u*)(Ks + kl * ATT_PITCH + sch * 16) = o; *(LAS v4u*)(Vs + kl * ATT_PITCH + sch * 16) = vr[p]; }
        }
        const int q0 = Q0 + 32 * wave;
        bf16x8 qf[4];
        norm_frag(qr, a.in[I_QNG] + h * 64, 0.125f * 1.4426950408889634f, hi, true, qf);
        { const int un = u + G; if (un < 4608) { int rb, h2, r2, Q02, S2, dlog2; ATT_DECODE(un, rb, h2, r2, Q02, S2, dlog2); ATT_LOADKV(rb, h2, r2, Q02, S2, dlog2, 0, 0, 6); ATT_LOADQ(rb, h2, r2, Q02, dlog2); } }
        __syncthreads();
        f32x16 st[5];
#pragma unroll
        for (int j = 0; j < 5; ++j) {
            const LAS unsigned char* kp = Ks + (32 * wave + 32 * j + ql) * ATT_PITCH + (8 * hi) * 2;
            f32x16 acc;
#pragma unroll
            for (int i = 0; i < 16; ++i) acc[i] = 0.f;
#pragma unroll
            for (int kk = 0; kk < 4; ++kk) acc = MFMA32(*(const LAS bf16x8*)(kp + 32 * kk), qf[kk], acc);
            st[j] = acc;
        }
        const LAS float* btl = BT + h * ATT_BTW + 31 - ql + 4 * hi;
        const int vlo = K0 < 0 ? -K0 : 0, vhi = (S - K0) < 384 ? (S - K0) : 384;
        const int klb = 32 * wave + 4 * hi - vlo; const unsigned vspan = (unsigned)(vhi - vlo);
        float mx = -3.0e38f;
#pragma unroll
        for (int j = 0; j < 5; ++j)
#pragma unroll
            for (int i = 0; i < 16; ++i) {
                const int cji = 32 * j + (i & 3) + 8 * (i >> 2);
                float sv = st[j][i] + btl[cji];
                sv = ((unsigned)(klb + cji) < vspan) ? sv : -1.0e30f;
                st[j][i] = sv; mx = fmaxf(mx, sv);
            }
        mx = fmaxf(mx, __shfl_xor(mx, 32));
        float den = 0.f;
#pragma unroll
        for (int j = 0; j < 5; ++j)
#pragma unroll
            for (int i = 0; i < 16; ++i) { const float p = __builtin_amdgcn_exp2f(st[j][i] - mx); st[j][i] = p; den += p; }
        den += __shfl_xor(den, 32);
        f32x16 ot[2];
#pragma unroll
        for (int i = 0; i < 16; ++i) { ot[0][i] = 0.f; ot[1][i] = 0.f; }
#pragma unroll
        for (int j = 0; j < 5; ++j) {
#pragma unroll
            for (int kk2 = 0; kk2 < 2; ++kk2) {
                v4u pb; pb.x = pk2(st[j][8 * kk2 + 0], st[j][8 * kk2 + 1]); pb.y = pk2(st[j][8 * kk2 + 2], st[j][8 * kk2 + 3]);
                pb.z = pk2(st[j][8 * kk2 + 4], st[j][8 * kk2 + 5]); pb.w = pk2(st[j][8 * kk2 + 6], st[j][8 * kk2 + 7]);
                const bf16x8 pfrag = __builtin_bit_cast(bf16x8, pb);
#pragma unroll
                for (int dt = 0; dt < 2; ++dt) {
                    LAS unsigned char* tp = Vs + troff + (32 * j + 16 * kk2) * ATT_PITCH + (32 * dt) * 2;
                    const v4i16_t lo = __builtin_amdgcn_ds_read_tr16_b64_v4i16((LAS v4i16_t*)tp);
                    const v4i16_t hv = __builtin_amdgcn_ds_read_tr16_b64_v4i16((LAS v4i16_t*)(tp + 8 * ATT_PITCH));
                    const bf16x8 av = __builtin_shufflevector(lo, hv, 0, 1, 2, 3, 4, 5, 6, 7);
                    ot[dt] = MFMA32(av, pfrag, ot[dt]);
                }
            }
        }
        const float inv = 1.0f / den;
        const size_t orow = (size_t)rowbase + ((size_t)(q0 + ql) << dlog) + r;
        bf16* op = OG + ((size_t)g * MT + orow) * 256 + hh * 64;
#pragma unroll
        for (int dt = 0; dt < 2; ++dt)
#pragma unroll
            for (int pr = 0; pr < 2; ++pr) { const int ie = 2 * pr, io = 2 * pr + 1;
                const unsigned e0 = pk2(ot[dt][4 * ie] * inv, ot[dt][4 * ie + 1] * inv), e1 = pk2(ot[dt][4 * ie + 2] * inv, ot[dt][4 * ie + 3] * inv);
                const unsigned o0 = pk2(ot[dt][4 * io] * inv, ot[dt][4 * io + 1] * inv), o1 = pk2(ot[dt][4 * io + 2] * inv, ot[dt][4 * io + 3] * inv);
                const auto s0 = __builtin_amdgcn_permlane32_swap(e0, o0, false, false), s1 = __builtin_amdgcn_permlane32_swap(e1, o1, false, false);
                v4u w4; w4.x = s0[0]; w4.y = s1[0]; w4.z = s0[1]; w4.w = s1[1];
                *(v4u*)(op + 32 * dt + 8 * (2 * pr + hi)) = w4; }
        if (hi == 0) LSE[((size_t)g * MT + orow) * 4 + hh] = (mx + __log2f(den)) * 0.6931471805599453f;
        __syncthreads();
    }
}
__device__ __forceinline__ void merge_rows(const Args& a, int gw, int NGW, int lane) {
    const bf16* OG = (const bf16*)(a.ws + WS_OG); const float* LSE = (const float*)(a.ws + WS_LSE); bf16* YAT = (bf16*)(a.ws + WS_YAT);
    const int hh = lane >> 4;
    for (int mb = gw; mb < MT; mb += 4 * NGW) {
        float l[4][3]; v2u o[4][3];
#pragma unroll
        for (int r = 0; r < 4; ++r) { const int m = mb + r * NGW; const int mc = m < MT ? m : mb;
#pragma unroll
            for (int g = 0; g < 3; ++g) { l[r][g] = LSE[((size_t)g * MT + mc) * 4 + hh]; o[r][g] = *(const v2u*)(OG + ((size_t)g * MT + mc) * 256 + 4 * lane); } }
#pragma unroll
        for (int r = 0; r < 4; ++r) { const int m = mb + r * NGW; if (m < MT) {
            const float mxl = fmaxf(l[r][0], fmaxf(l[r][1], l[r][2]));
            float a0 = __expf(l[r][0] - mxl), a1 = __expf(l[r][1] - mxl), a2 = __expf(l[r][2] - mxl); const float is = 1.0f / (a0 + a1 + a2); a0 *= is; a1 *= is; a2 *= is;
            const v2u o0 = o[r][0], o1 = o[r][1], o2 = o[r][2];
            v2u w;
            w.x = pk2(a0 * pg8::bf_lo(o0.x) + a1 * pg8::bf_lo(o1.x) + a2 * pg8::bf_lo(o2.x), a0 * pg8::bf_hi(o0.x) + a1 * pg8::bf_hi(o1.x) + a2 * pg8::bf_hi(o2.x));
            w.y = pk2(a0 * pg8::bf_lo(o0.y) + a1 * pg8::bf_lo(o1.y) + a2 * pg8::bf_lo(o2.y), a0 * pg8::bf_hi(o0.y) + a1 * pg8::bf_hi(o1.y) + a2 * pg8::bf_hi(o2.y));
            *(v2u*)(YAT + (size_t)m * 256 + 4 * lane) = w; } }
    }
}

constexpr int HT_PITCH = 260;
constexpr int HW_OFF = 40960;
__device__ __forceinline__ void hy_weights_to_lds(const Args& a, LAS unsigned char* lds, int tid) {
    LAS float* W = (LAS float*)(lds + HW_OFF);
    for (int i = tid; i < 3 * ZW; i += 512) W[i] = a.in[I_CONVW][i];
    for (int i = tid; i < ZW; i += 512) W[3 * ZW + i] = a.in[I_CONVB][i];
    __syncthreads();
}
__device__ __forceinline__ void hy_load6(const bf16* ZHY, int col, int mr0, int L, v4u (&z)[6]) {
    const bool lv = (mr0 & (L - 1)) != 0, rv = ((mr0 + 4) & (L - 1)) != 0;
#pragma unroll
    for (int i = 0; i < 6; ++i) { const bool ok = (i == 0) ? lv : (i == 5 ? rv : true);
        v4u u = {0u, 0u, 0u, 0u}; if (ok) u = *(const v4u*)(ZHY + (size_t)(mr0 + i - 1) * ZW + col); z[i] = u; }
}
__device__ __forceinline__ void hy_conv4x8(const v4u (&z)[6], const LAS float* W, int col, float (&o)[4][8]) {
    float w0[8], w1[8], w2[8], bb[8];
#pragma unroll
    for (int h4 = 0; h4 < 2; ++h4) { const f32x4 a0 = *(const LAS f32x4*)(W + col + 4 * h4), a1 = *(const LAS f32x4*)(W + ZW + col + 4 * h4), a2 = *(const LAS f32x4*)(W + 2 * ZW + col + 4 * h4), a3 = *(const LAS f32x4*)(W + 3 * ZW + col + 4 * h4);
#pragma unroll
        for (int k = 0; k < 4; ++k) { w0[4 * h4 + k] = a0[k]; w1[4 * h4 + k] = a1[k]; w2[4 * h4 + k] = a2[k]; bb[4 * h4 + k] = a3[k]; } }
#pragma unroll
    for (int j = 0; j < 4; ++j)
#pragma unroll
        for (int k = 0; k < 4; ++k) {
            o[j][2 * k]     = pg8::bf_lo(z[j][k]) * w0[2 * k]     + pg8::bf_lo(z[j + 1][k]) * w1[2 * k]     + pg8::bf_lo(z[j + 2][k]) * w2[2 * k]     + bb[2 * k];
            o[j][2 * k + 1] = pg8::bf_hi(z[j][k]) * w0[2 * k + 1] + pg8::bf_hi(z[j + 1][k]) * w1[2 * k + 1] + pg8::bf_hi(z[j + 2][k]) * w2[2 * k + 1] + bb[2 * k + 1]; }
}
__device__ __forceinline__ void hyena_prep(const Args& a, LAS unsigned char* lds, int bid, int G, int tid) {
    const bf16* ZHY = (const bf16*)(a.ws + WS_ZHY); bf16* UCT = (bf16*)(a.ws + WS_UCT);
    LAS unsigned short* tile = (LAS unsigned short*)lds; const LAS float* W = (const LAS float*)(lds + HW_OFF);
    const int cg = tid & 7, tq = tid >> 3, NT = (MT / 256) * 12;
    hy_weights_to_lds(a, lds, tid);
    v4u n1[6], nv[6];
    if (bid < NT) { const int m0 = (bid / 12) * 256, c0 = (bid % 12) * 64, L = m0 < MP ? LP : LS; hy_load6(ZHY, 768 + c0 + 8 * cg, m0 + 4 * tq, L, n1); hy_load6(ZHY, 1536 + c0 + 8 * cg, m0 + 4 * tq, L, nv); }
    for (int it = bid; it < NT; it += G) {
        const int m0 = (it / 12) * 256, c0 = (it % 12) * 64, ca = c0 + 8 * cg;
        v4u z1[6], zv[6];
#pragma unroll
        for (int i = 0; i < 6; ++i) { z1[i] = n1[i]; zv[i] = nv[i]; }
        { const int itn = it + G; if (itn < NT) { const int m0n = (itn / 12) * 256, c0n = (itn % 12) * 64, Ln = m0n < MP ? LP : LS; hy_load6(ZHY, 768 + c0n + 8 * cg, m0n + 4 * tq, Ln, n1); hy_load6(ZHY, 1536 + c0n + 8 * cg, m0n + 4 * tq, Ln, nv); } }
        float x1[4][8], vv[4][8];
        hy_conv4x8(z1, W, 768 + ca, x1); hy_conv4x8(zv, W, 1536 + ca, vv);
#pragma unroll
        for (int i = 0; i < 8; ++i) { v2u w; w.x = pk2(x1[0][i] * vv[0][i], x1[1][i] * vv[1][i]); w.y = pk2(x1[2][i] * vv[2][i], x1[3][i] * vv[3][i]);
            *(LAS v2u*)(tile + (8 * cg + i) * HT_PITCH + 4 * tq) = w; }
        __syncthreads();
        { const int c = tid >> 3, piece = tid & 7;
          const LAS v2u* sp = (const LAS v2u*)(tile + c * HT_PITCH + piece * 32);
          v4u* dp = (v4u*)(UCT + (size_t)(c0 + c) * MT + m0 + piece * 32);
#pragma unroll
          for (int k = 0; k < 4; ++k) { const v2u lo = sp[2 * k], hv = sp[2 * k + 1]; v4u o; o.x = lo.x; o.y = lo.y; o.z = hv.x; o.w = hv.y; dp[k] = o; } }
        __syncthreads();
    }
}
__device__ __forceinline__ void hyena_gate(const Args& a, LAS unsigned char* lds, int bid, int G, int tid) {
    const bf16* ZHY = (const bf16*)(a.ws + WS_ZHY); const bf16* UCT = (const bf16*)(a.ws + WS_UCT); bf16* YH = (bf16*)(a.ws + WS_YH);
    LAS unsigned short* tile = (LAS unsigned short*)lds; const LAS float* W = (const LAS float*)(lds + HW_OFF);
    const int cg = tid & 7, tq = tid >> 3, NT = (MT / 256) * 12, yc = tid >> 3, yp = tid & 7;
    hy_weights_to_lds(a, lds, tid);
    v4u n0[6], ny[4];
    if (bid < NT) { const int m0 = (bid / 12) * 256, c0 = (bid % 12) * 64, L = m0 < MP ? LP : LS; hy_load6(ZHY, c0 + 8 * cg, m0 + 4 * tq, L, n0);
        const v4u* dp = (const v4u*)(UCT + (size_t)(c0 + yc) * MT + m0 + yp * 32);
#pragma unroll
        for (int k = 0; k < 4; ++k) ny[k] = dp[k]; }
    for (int it = bid; it < NT; it += G) {
        const int m0 = (it / 12) * 256, c0 = (it % 12) * 64, mr0 = m0 + 4 * tq, ca = c0 + 8 * cg;
        v4u z0[6];
#pragma unroll
        for (int i = 0; i < 6; ++i) z0[i] = n0[i];
        { LAS v2u* sp = (LAS v2u*)(tile + yc * HT_PITCH + yp * 32);
#pragma unroll
          for (int k = 0; k < 4; ++k) { const v4u o = ny[k]; v2u lo, hv; lo.x = o.x; lo.y = o.y; hv.x = o.z; hv.y = o.w; sp[2 * k] = lo; sp[2 * k + 1] = hv; } }
        { const int itn = it + G; if (itn < NT) { const int m0n = (itn / 12) * 256, c0n = (itn % 12) * 64, Ln = m0n < MP ? LP : LS; hy_load6(ZHY, c0n + 8 * cg, m0n + 4 * tq, Ln, n0);
            const v4u* dp = (const v4u*)(UCT + (size_t)(c0n + yc) * MT + m0n + yp * 32);
#pragma unroll
            for (int k = 0; k < 4; ++k) ny[k] = dp[k]; } }
        float x0[4][8];
        hy_conv4x8(z0, W, ca, x0);
        __syncthreads();
        float y[4][8];
#pragma unroll
        for (int i = 0; i < 8; ++i) { const v2u w = *(const LAS v2u*)(tile + (8 * cg + i) * HT_PITCH + 4 * tq);
            y[0][i] = pg8::bf_lo(w.x); y[1][i] = pg8::bf_hi(w.x); y[2][i] = pg8::bf_lo(w.y); y[3][i] = pg8::bf_hi(w.y); }
#pragma unroll
        for (int j = 0; j < 4; ++j) { v4u o;
#pragma unroll
            for (int k = 0; k < 4; ++k) o[k] = pk2(x0[j][2 * k] * y[j][2 * k], x0[j][2 * k + 1] * y[j][2 * k + 1]);
            *(v4u*)(YH + (size_t)(mr0 + j) * DH + ca) = o; }
        __syncthreads();
    }
}

#define FFT_LD(IDX) do { _Pragma("unroll") for (int e = 0; e < 32; ++e) v[e] = X[IDX(tl_, e)]; } while (0)
#define FFT_ST(IDX) do { _Pragma("unroll") for (int e = 0; e < 32; ++e) X[IDX(tl_, e)] = v[e]; } while (0)
#define FFT_PASS() const int tl_ = lnd(tid)
typedef cf2 f32x2v;
__device__ __forceinline__ int fft_pA(int t, int e) { return ((t ^ (t >> 5)) ^ (16 * (e & 1))) + 512 * e; }
__device__ __forceinline__ int fft_pB(int t, int e) { return ((t >> 4) << 9) + 32 * (e >> 1) + (((t & 15) ^ (e >> 1)) + 16 * ((e & 1) ^ ((t >> 4) & 1))); }
__device__ __forceinline__ int fft_pC(int t, int e) { return 32 * t + (e ^ (t & 31)); }
__device__ __forceinline__ void kraw_items(const Args& a, int gw, int NGW, int lane) {
    const float* H3 = (const float*)(a.ws + WS_H3); float* KR = (float*)(a.ws + WS_KRAW);
    for (int it = gw; it < 192 * 32; it += NGW) {
        const int pg = it >> 5, cgp = it & 31, p = pg * 64 + lane, c0 = cgp * 48;
        float h[64];
#pragma unroll
        for (int q = 0; q < 16; ++q) { const f32x4 t = *(const f32x4*)(H3 + (size_t)p * 64 + 4 * q); h[4 * q] = t.x; h[4 * q + 1] = t.y; h[4 * q + 2] = t.z; h[4 * q + 3] = t.w; }
        const int grp = p >= LP, tpos = p - grp * LP, L = grp ? LS : LP;
        const float tt = (float)tpos * (1.0f / (float)(L - 1));
#pragma unroll 1
        for (int cb = 0; cb < 4; ++cb) {
            const float* wr = a.in[I_FWOUT] + lane * 1536 + c0 + 12 * cb;
            const f32x4 w0 = *(const f32x4*)(wr), w1 = *(const f32x4*)(wr + 4), w2 = *(const f32x4*)(wr + 8);
            float wv[12] = {w0.x, w0.y, w0.z, w0.w, w1.x, w1.y, w1.z, w1.w, w2.x, w2.y, w2.z, w2.w};
#pragma unroll
            for (int ci = 0; ci < 12; ++ci) { const int c = c0 + 12 * cb + ci;
                float acc = 0.f;
#pragma unroll
                for (int jj = 0; jj < 64; ++jj) acc += h[jj] * __builtin_bit_cast(float, __builtin_amdgcn_readlane(__builtin_bit_cast(int, wv[ci]), jj));
                const int cm = c % 768;
                const float delta = fabsf(-3.0701134573253945f + (float)cm * ((-15.350567286626973f + 3.0701134573253945f) / 767.0f));
                KR[(size_t)c * (LP + LS) + p] = acc * __expf(-tt * delta); }
        }
    }
}
__device__ __forceinline__ void filter_phase(const Args& a, LAS unsigned char* lds, int bid, int G, int tid) {
    LAS f32x2v* X = (LAS f32x2v*)lds;
    LAS float* red = (LAS float*)(lds + 131072);
    const float* KR = (const float*)(a.ws + WS_KRAW);
    unsigned* KS = (unsigned*)(a.ws + WS_KSPEC);
    const int lane = tid & 63, wave = tid >> 6;
    for (int it = bid; it < 1536; it += G) {
        const int grp = it >= 768, c = it - grp * 768, L = grp ? LS : LP;
        const float* kf = KR + (size_t)c * (LP + LS) + grp * LP; const float* kb = kf + (size_t)768 * (LP + LS);
        cf2 v[32]; float asum = 0.f;
        { const int tl = lnd(tid);
#pragma unroll
          for (int e = 0; e < 32; ++e) {
            const int i = tl + 512 * e; float val = 0.f;
            if (e < 16) { if (i < L) val = kf[i]; } else { const int tp = 16384 - i; if (tp >= 1 && tp <= L - 1) val = kb[tp]; }
            v[e].x = val; v[e].y = 0.f; asum += fabsf(val);
          } }
        asum = wave_sum(asum);
        if (lane == 0) red[wave] = asum;
        __syncthreads();
        float tot = 0.f;
#pragma unroll
        for (int w = 0; w < 8; ++w) tot += red[w];
        const float sc = 1.0f / (tot * 16384.0f), dd = a.in[I_HYD][c] * (1.0f / 16384.0f);
        { FFT_PASS(); dif_stages<5, 0>(v, tl_, 9); FFT_ST(fft_pA); } __syncthreads();
        { FFT_PASS(); FFT_LD(fft_pB); dif_stages<5, 0>(v, tl_ & 15, 4); FFT_ST(fft_pB); } __syncthreads();
        { FFT_PASS(); FFT_LD(fft_pC); dif_stages<4, 0, true>(v, 0, 0); dif_stages<4, 16, true>(v, 0, 0);
          unsigned* kp = KS + (size_t)it * 16384 + tl_;
#pragma unroll
          for (int e = 0; e < 32; ++e) kp[e * 512] = pk2(v[e].x * sc + dd, v[e].y * sc); }
        __syncthreads();
    }
}
struct FftItem { int rowA, rowB, offB, kidx; unsigned short* base; };
__device__ __forceinline__ void fft_item(int it, bf16* UCT, FftItem& I, int& r0, int& r1, int& r2, int& r3, int& f1) {
    if (it < 3072) { const int c = it >> 2, bp = it & 3; r0 = (2 * bp) * LP; r1 = r0 + LP; r2 = r0 + 4096; r3 = r1 + 4096; f1 = 4096; I.kidx = c; I.base = UCT + (size_t)c * MT; }
    else { const int j = it - 3072, c = j >> 1, half = j & 1; r0 = MP + (4 * half) * LS; r1 = r0 + LS; r2 = r0 + 2 * LS; r3 = r2 + LS; f1 = 8192; I.kidx = 768 + c; I.base = UCT + (size_t)c * MT; }
}
__device__ __forceinline__ void fftconv_phase(const Args& a, LAS unsigned char* lds, int bid, int G, int tid) {
    LAS f32x2v* X = (LAS f32x2v*)lds;
    bf16* UCT = (bf16*)(a.ws + WS_UCT);
    const unsigned* KS = (const unsigned*)(a.ws + WS_KSPEC);
    const int vid = (G % 8 == 0) ? (bid >> 3) + (G >> 3) * (bid & 7) : bid;
    v4u nx[4];
    { FftItem I; int r0, r1, r2, r3, f1; if (vid < 4608) { fft_item(vid, UCT, I, r0, r1, r2, r3, f1); const int t8 = 8 * lnd(tid);
        nx[0] = *(const v4u*)(I.base + r0 + t8); nx[1] = *(const v4u*)(I.base + r1 + t8); nx[2] = *(const v4u*)(I.base + r2 + t8); nx[3] = *(const v4u*)(I.base + r3 + t8); } }
    for (int it = vid; it < 4608; it += G) {
        FftItem I; int r0, r1, r2, r3, f1; fft_item(it, UCT, I, r0, r1, r2, r3, f1);
        { const int tl = lnd(tid); const f32x2v z = {0.f, 0.f};
#pragma unroll
          for (int k = 0; k < 4; ++k) { f32x2v s0, s1, s2, s3;
              s0.x = pg8::bf_lo(nx[0][k]); s0.y = pg8::bf_lo(nx[1][k]); s1.x = pg8::bf_hi(nx[0][k]); s1.y = pg8::bf_hi(nx[1][k]);
              s2.x = pg8::bf_lo(nx[2][k]); s2.y = pg8::bf_lo(nx[3][k]); s3.x = pg8::bf_hi(nx[2][k]); s3.y = pg8::bf_hi(nx[3][k]);
              X[fft_swz(8 * tl + 2 * k)] = s0; X[fft_swz(8 * tl + 2 * k + 1)] = s1; X[fft_swz(f1 + 8 * tl + 2 * k)] = s2; X[fft_swz(f1 + 8 * tl + 2 * k + 1)] = s3; }
          const int z0 = (f1 == 4096) ? 8192 : 4096, z1 = 12288;
#pragma unroll
          for (int k = 0; k < 8; ++k) { X[fft_swz(z0 + tl + 512 * k)] = z; X[fft_swz(z1 + tl + 512 * k)] = z; } }
        { const int itn = it + G; if (itn < 4608) { FftItem J; int q0, q1, q2, q3, g1; fft_item(itn, UCT, J, q0, q1, q2, q3, g1); const int t8 = 8 * lnd(tid);
            nx[0] = *(const v4u*)(J.base + q0 + t8); nx[1] = *(const v4u*)(J.base + q1 + t8); nx[2] = *(const v4u*)(J.base + q2 + t8); nx[3] = *(const v4u*)(J.base + q3 + t8); } }
        __syncthreads();
        cf2 v[32];
        { FFT_PASS(); FFT_LD(fft_pA); dif_stages<5, 0>(v, tl_, 9); FFT_ST(fft_pA); } __syncthreads();
        unsigned kq[32];
        { const unsigned* kp = KS + (size_t)I.kidx * 16384 + lnd(tid);
#pragma unroll
          for (int e = 0; e < 32; ++e) kq[e] = kp[e * 512]; }
        { FFT_PASS(); FFT_LD(fft_pB); dif_stages<5, 0>(v, tl_ & 15, 4); FFT_ST(fft_pB); } __syncthreads();
        { FFT_PASS(); FFT_LD(fft_pC); dif_stages<4, 0, true>(v, 0, 0); dif_stages<4, 16, true>(v, 0, 0);
#pragma unroll
          for (int e = 0; e < 32; ++e) { f32x2v kk; kk.x = pg8::bf_lo(kq[e]); kk.y = pg8::bf_hi(kq[e]); v[e] = cmul(v[e], kk); }
          dit_stages<4, 0, true>(v, 0, 0); dit_stages<4, 16, true>(v, 0, 0); FFT_ST(fft_pC); } __syncthreads();
        { FFT_PASS(); FFT_LD(fft_pB); dit_stages<5, 0>(v, tl_ & 15, 4); FFT_ST(fft_pB); } __syncthreads();
        { FFT_PASS(); FFT_LD(fft_pA); dit_stages<5, 0>(v, tl_, 9); FFT_ST(fft_pA); } __syncthreads();
        { const int tl = lnd(tid); v4u o0, o1, o2, o3;
#pragma unroll
          for (int k = 0; k < 4; ++k) { const f32x2v s0 = X[fft_swz(8 * tl + 2 * k)], s1 = X[fft_swz(8 * tl + 2 * k + 1)], s2 = X[fft_swz(f1 + 8 * tl + 2 * k)], s3 = X[fft_swz(f1 + 8 * tl + 2 * k + 1)];
              o0[k] = pk2(s0.x, s1.x); o1[k] = pk2(s0.y, s1.y); o2[k] = pk2(s2.x, s3.x); o3[k] = pk2(s2.y, s3.y); }
          *(v4u*)(I.base + r0 + 8 * tl) = o0; *(v4u*)(I.base + r1 + 8 * tl) = o1; *(v4u*)(I.base + r2 + 8 * tl) = o2; *(v4u*)(I.base + r3 + 8 * tl) = o3; }
        __syncthreads();
    }
}

#define XB_TMO      128
#define XB_XCNT(j)  (256  + 64 * (j))
#define XB_XSUB(j)  (1280 + 64 * (j))
#define XB_XGEN(j)  (2304 + 64 * (j))
#define XB_TOP      3328
#define XB_TOPGEN   3392
#define XCD_BAR_WORDS 3456
#define XB_SPIN_CAP (1u << 18)

__device__ __forceinline__ unsigned xb_ld(unsigned* p)              { return __hip_atomic_load(p, __ATOMIC_RELAXED, __HIP_MEMORY_SCOPE_AGENT); }
__device__ __forceinline__ unsigned xb_add(unsigned* p, unsigned v) { return __hip_atomic_fetch_add(p, v, __ATOMIC_RELAXED, __HIP_MEMORY_SCOPE_AGENT); }
__device__ __forceinline__ unsigned xb_xcc_id() { return (unsigned)__builtin_amdgcn_s_getreg((3 << 11) | 20) & 0xFu; }
#define XB_SPIN(cond, bar) do { unsigned _sp = 0; while (cond) { __builtin_amdgcn_s_sleep(1); \
    if ((++_sp & 255u) == 0u) { if (xb_ld(&(bar)[XB_TMO])) break; if (_sp > XB_SPIN_CAP) { atomicAdd(&(bar)[XB_TMO], 1u); break; } } } } while (0)

struct XcdBarrier {
    unsigned* bar; unsigned x;
    volatile LAS unsigned* st;
};

__device__ __forceinline__ XcdBarrier xcd_barrier_post(unsigned* bar, volatile LAS unsigned* st) {
    XcdBarrier b; b.bar = bar; b.x = xb_xcc_id(); b.st = st;
    if (threadIdx.x == 0) (void)xb_add(&bar[XB_XCNT(b.x)], 1u);
    return b;
}
__device__ __forceinline__ void xcd_barrier_complete(unsigned* bar, unsigned x, unsigned& nloc, unsigned& nx) {
    const unsigned G = gridDim.x * gridDim.y * gridDim.z;
    unsigned sum, cnt, mine, sp = 0u;
    for (;;) {
        sum = 0u; cnt = 0u; mine = 0u;
#pragma unroll
        for (unsigned j = 0; j < 16; ++j) { const unsigned c = xb_ld(&bar[XB_XCNT(j)]); sum += c; cnt += (c > 0u) ? 1u : 0u; mine = (j == x) ? c : mine; }
        if (sum == G) break;
        __builtin_amdgcn_s_sleep(1);
        if ((++sp & 255u) == 0u) { if (xb_ld(&bar[XB_TMO])) break; if (sp > XB_SPIN_CAP) { atomicAdd(&bar[XB_TMO], 1u); break; } }
    }
    nloc = mine > 0u ? mine : 1u; nx = cnt > 0u ? cnt : 1u;
}

__device__ __forceinline__ void xcd_barrier(const XcdBarrier& b) {
    asm volatile("s_waitcnt vmcnt(0)" ::: "memory");
    __syncthreads();
    if (threadIdx.x == 0) {
        unsigned* bar = b.bar;
        __builtin_amdgcn_s_waitcnt(0);
        unsigned nloc = b.st[0], nx = b.st[1];
        if (nloc == 0u) { xcd_barrier_complete(bar, b.x, nloc, nx); b.st[0] = nloc; b.st[1] = nx; }
        const unsigned old = xb_add(&bar[XB_XSUB(b.x)], 1u);
        const unsigned gen = old / nloc;
        if (old + 1u == (gen + 1u) * nloc) {
            __builtin_amdgcn_fence(__ATOMIC_RELEASE, "agent");
            asm volatile("s_waitcnt vmcnt(0)" ::: "memory");
            const unsigned og = xb_add(&bar[XB_TOP], 1u);
            const unsigned tg = og / nx;
            if (og + 1u == (tg + 1u) * nx) xb_add(&bar[XB_TOPGEN], 1u);
            else XB_SPIN(xb_ld(&bar[XB_TOPGEN]) == tg, bar);
            __builtin_amdgcn_fence(__ATOMIC_ACQUIRE, "agent");
            xb_add(&bar[XB_XGEN(b.x)], 1u);
            asm volatile("s_waitcnt vmcnt(0)" ::: "memory");
        } else {
            XB_SPIN(xb_ld(&bar[XB_XGEN(b.x)]) == gen, bar);
            __builtin_amdgcn_fence(__ATOMIC_ACQUIRE, "agent");
            asm volatile("s_waitcnt vmcnt(0)" ::: "memory");
        }
    }
    __syncthreads();
}

template <int PHM> __global__ void __launch_bounds__(512, 2) mk_fwd(Args karg) {
    extern __shared__ __attribute__((aligned(16))) unsigned char lds_raw[];
    LAS unsigned char* lds = (LAS unsigned char*)lds_raw;
    const int bid = blockIdx.x, G = gridDim.x, NGW = G * 8;
#define PH_IDS() const int tid = lnd((int)threadIdx.x), lane = tid & 63, wave = __builtin_amdgcn_readfirstlane(tid >> 6), gw = bid * 8 + wave; (void)lane; (void)gw
    typedef const __attribute__((address_space(4))) Args* KArgs;
    KArgs kp = (KArgs)__builtin_amdgcn_kernarg_segment_ptr();
#define PH_ARGS() KArgs kq_ = kp; asm volatile("" : "+s"(kq_)); const Args a = *(const Args*)kq_; unsigned char* ws = a.ws; const float* MOD = (const float*)(ws + WS_MOD); \
    bf16* WIN = (bf16*)(ws + WS_WIN); bf16* WHB = (bf16*)(ws + WS_WHB); bf16* WAB = (bf16*)(ws + WS_WAB); bf16* WOUT = (bf16*)(ws + WS_WOUT); bf16* WUP = (bf16*)(ws + WS_WUP); bf16* WDN = (bf16*)(ws + WS_WDN); \
    (void)MOD; (void)WIN; (void)WHB; (void)WAB; (void)WOUT; (void)WUP; (void)WDN
    constexpr bool MULTI = (PHM & (PHM - 1)) != 0;
    XcdBarrier xbar; xbar.bar = (unsigned*)(karg.ws + WS_BAR); xbar.x = 0; xbar.st = nullptr;
    if constexpr (MULTI) {
        volatile LAS unsigned* stw = (volatile LAS unsigned*)(lds + LDS_BYTES - 64);
        if (threadIdx.x < 2) stw[threadIdx.x] = 0u;
        __syncthreads();
        xbar = xcd_barrier_post((unsigned*)(karg.ws + WS_BAR), stw);
    }
#define GRID_SYNC(k) do { if constexpr (MULTI) { if ((k) == 0) cg::this_grid().sync(); else xcd_barrier(xbar); } } while (0)
#define IN(k) (((PHM >> (k)) & 1) && karg.ph_lo <= (k) && (k) < karg.ph_hi)
#ifndef REP_MASK
#define REP_MASK 0
#endif
#define REPS(k) for (int rep_ = 0; rep_ < (((REP_MASK >> (k)) & 1) ? 2 : 1); ++rep_)
#define SEAM(k) do { if (IN(k) && IN((k) + 1)) GRID_SYNC(k); } while (0)

    if (IN(0)) REPS(0) { PH_ARGS(); PH_IDS();
        p0_mod(a, lds, bid, G, tid);
        LAS float* scr = (LAS float*)(lds + wave * 16384);
        constexpr int I_IN = (DM / 64) * (NIN / 32), I_HB = (DH / 64) * (DM / 32), I_AB = (256 / 64) * (DM / 32), I_OUT = (DM / 64) * (DM / 32), I_UP = (DM / 64) * (DFF / 32), I_DN = (DFF / 64) * (DM / 32);
        constexpr int NITEMS = I_IN + I_HB + I_AB + I_OUT + I_UP + I_DN;
        for (int it = gw; it < NITEMS; it += NGW) {
            int r = it;
            if (r < I_IN) { const int n0 = 32 * (r % (NIN / 32)); const int off = n0 < 2304 ? 3072 : (n0 < 5376 ? -2304 : 0);
                p0_transpose_item(a.in[I_WIN], DM, NIN, WIN, off, scr, r, lane); continue; } r -= I_IN;
            if (r < I_HB) { p0_transpose_item(a.in[I_WHB], DH, DM, WHB, 0, scr, r, lane); continue; } r -= I_HB;
            if (r < I_AB) { p0_transpose_item(a.in[I_WAB], 256, DM, WAB, 0, scr, r, lane); continue; } r -= I_AB;
            if (r < I_OUT) { p0_transpose_item(a.in[I_WOUT], DM, DM, WOUT, 0, scr, r, lane); continue; } r -= I_OUT;
            if (r < I_UP) { p0_transpose_item(a.in[I_WUP], DM, DFF, WUP, 0, scr, r, lane); continue; } r -= I_UP;
            p0_transpose_item(a.in[I_WDN], DFF, DM, WDN, 0, scr, r, lane);
        }
        p0_h3(a, gw, NGW, lane);
        __syncthreads();
    }
    SEAM(0);
    if (IN(1)) REPS(1) { PH_ARGS(); PH_IDS(); prep_rows<false>(a.in[I_XP], a.in[I_XS], nullptr, a.in[I_N1G], MOD, 0, 1024, (bf16*)(ws + WS_U1), gw, NGW, lane); kraw_items(a, gw, NGW, lane); }
    SEAM(1);
    if (IN(2)) REPS(2) { PH_ARGS();
        pg8::Gemm g{(const bf16*)(ws + WS_U1), WIN, MT, QW + 768, DM}; pg8::StaticOrder S; S.init(MT, QW + 768, G, bid);
        pg8::EpiB<1> E{(bf16*)(ws + WS_QKV), QW, nullptr, (bf16*)a.out, QW / 256, 0};
        pg8::gemm_phase<pg8::EpiB<1>, pg8::StaticOrder, GEMM_ALIGN, GEMM_SP2>(lds, g, S, E);
    }
    SEAM(2);
    if (IN(3)) REPS(3) { PH_ARGS(); PH_IDS(); attn_phase(a, lds, bid, G, tid); __syncthreads(); }
    SEAM(3);
    if (IN(4)) REPS(4) { PH_ARGS(); { PH_IDS();
        merge_rows(a, gw, NGW, lane); }
        pg8::Gemm g{(const bf16*)(ws + WS_U1), WIN + (size_t)3072 * DM, MT, ZW + GW - 768, DM}; pg8::StaticOrder S; S.init(MT, ZW + GW - 768, G, bid);
        pg8::EpiB<1> E{(bf16*)(ws + WS_ZHY), ZW, nullptr, (bf16*)a.out, ZW / 256, 768};
        pg8::gemm_phase<pg8::EpiB<1>, pg8::StaticOrder, GEMM_ALIGN, GEMM_SP2>(lds, g, S, E);
    }
    SEAM(4);
    if (IN(5)) REPS(5) { PH_ARGS(); PH_IDS(); hyena_prep(a, lds, bid, G, tid); filter_phase(a, lds, bid, G, tid); }
    SEAM(5);
    if (IN(6)) REPS(6) { PH_ARGS(); PH_IDS(); fftconv_phase(a, lds, bid, G, tid); }
    SEAM(6);
    if (IN(7)) REPS(7) { PH_ARGS(); PH_IDS(); hyena_gate(a, lds, bid, G, tid); }
    SEAM(7);
    if (IN(8)) REPS(8) { PH_ARGS();
        pg8::Gemm g{(const bf16*)(ws + WS_YH), WHB, MT, DM, DH}; pg8::StaticOrder S; S.init(MT, DM, G, bid);
        pg8::EpiB<2> E{(bf16*)(ws + WS_T1), DM, (const bf16*)a.out, nullptr, 0};
        pg8::gemm_phase<pg8::EpiB<2>, pg8::StaticOrder, GEMM_ALIGN, GEMM_SP2>(lds, g, S, E);
    }
    if (IN(9)) REPS(9) { PH_ARGS();
        pg8::Gemm g{(const bf16*)(ws + WS_YAT), WAB, MT, DM, 256}; pg8::StaticOrder S; S.init(MT, DM, G, bid);
        pg8::EpiB<3> E{(bf16*)(ws + WS_T1), DM, (const bf16*)a.out, nullptr, 0};
        pg8::gemm_phase<pg8::EpiB<3>, pg8::StaticOrder, GEMM_ALIGN, GEMM_SP2>(lds, g, S, E);
    }
    SEAM(9);
    if (IN(10)) REPS(10) { PH_ARGS();
        pg8::Gemm g{(const bf16*)(ws + WS_T1), WOUT, MT, DM, DM}; pg8::StaticOrder S; S.init(MT, DM, G, bid);
        pg8::EpiH E{a.in[I_XP], a.in[I_XS], (bf16*)(ws + WS_H16), MOD + 2048};
        pg8::gemm_phase<pg8::EpiH, pg8::StaticOrder, GEMM_ALIGN, GEMM_SP2>(lds, g, S, E);
    }
    SEAM(10);
    if (IN(11)) REPS(11) { PH_ARGS(); PH_IDS(); prep_rows<true>(nullptr, nullptr, (const bf16*)(ws + WS_H16), a.in[I_N2G], MOD, 3072, 4096, (bf16*)(ws + WS_U2), gw, NGW, lane); }
    SEAM(11);
#define MLP_HALF(kup, kdn, half) \
    if (IN(kup)) REPS(kup) { PH_ARGS(); \
        pg8::Gemm g{(const bf16*)(ws + WS_U2) + (size_t)(half) * (MT / 2) * DM, WUP, MT / 2, DFF, DM}; pg8::StaticOrder S; S.init(MT / 2, DFF, G, bid); \
        pg8::EpiB<5> E{(bf16*)(ws + WS_FF), DFF, nullptr, nullptr, 0}; \
        pg8::gemm_phase<pg8::EpiB<5>, pg8::StaticOrder, GEMM_ALIGN, GEMM_SP2>(lds, g, S, E); \
    } \
    SEAM(kup); \
    if (IN(kdn)) REPS(kdn) { PH_ARGS(); \
        pg8::Gemm g{(const bf16*)(ws + WS_FF), WDN, MT / 2, DM, DFF}; pg8::StaticOrder S; S.init(MT / 2, DM, G, bid); \
        pg8::EpiF E{(const bf16*)(ws + WS_H16), a.out, MOD + 5120, (half) * (MT / 2)}; \
        pg8::gemm_phase<pg8::EpiF, pg8::StaticOrder, GEMM_ALIGN, GEMM_SP2>(lds, g, S, E); \
    }
    MLP_HALF(12, 13, 0)
    SEAM(13);
    MLP_HALF(14, 15, 1)
}

extern "C" void kernel_launch(void* const* d_in, const int* in_sizes, int n_in, void* d_out, int out_size, void* d_ws, size_t ws_size, hipStream_t stream) {
    static int grid = 0;
    if (grid == 0) {
        if (n_in != 28 || in_sizes[0] != MP * DM || in_sizes[1] != MS * DM || out_size != MT * DM || ws_size < WS_END) {
            fprintf(stderr, "kernel_launch: unexpected shapes (n_in %d, in0 %d, out %d, ws %zu); nothing launched\n", n_in, n_in > 0 ? in_sizes[0] : -1, out_size, ws_size); grid = -1; return; }
        int dev = 0, cus = 0, per_cu = 0;
        if (hipGetDevice(&dev) != hipSuccess || hipDeviceGetAttribute(&cus, hipDeviceAttributeMultiprocessorCount, dev) != hipSuccess) { grid = -1; return; }
#if MK_PER_PHASE
        const void* fns[NPHASE] = {(const void*)mk_fwd<1>, (const void*)mk_fwd<2>, (const void*)mk_fwd<4>, (const void*)mk_fwd<8>, (const void*)mk_fwd<16>, (const void*)mk_fwd<32>, (const void*)mk_fwd<64>, (const void*)mk_fwd<128>,
                                   (const void*)mk_fwd<256>, (const void*)mk_fwd<512>, (const void*)mk_fwd<1024>, (const void*)mk_fwd<2048>, (const void*)mk_fwd<4096>, (const void*)mk_fwd<8192>, (const void*)mk_fwd<16384>, (const void*)mk_fwd<32768>};
        for (int p = 0; p < NPHASE; ++p) if (hipFuncSetAttribute(fns[p], hipFuncAttributeMaxDynamicSharedMemorySize, LDS_BYTES) != hipSuccess) { fprintf(stderr, "kernel_launch: hipFuncSetAttribute failed\n"); grid = -1; return; }
#else
        if (hipFuncSetAttribute((const void*)mk_fwd<0xffff>, hipFuncAttributeMaxDynamicSharedMemorySize, LDS_BYTES) != hipSuccess) { fprintf(stderr, "kernel_launch: hipFuncSetAttribute failed\n"); grid = -1; return; }
        if (hipOccupancyMaxActiveBlocksPerMultiprocessor(&per_cu, (const void*)mk_fwd<0xffff>, 512, LDS_BYTES) != hipSuccess || per_cu < 1) { fprintf(stderr, "kernel_launch: occupancy query says %d\n", per_cu); per_cu = 1; }
#endif
        (void)per_cu; (void)hipGetLastError();
        grid = cus * 1;
    }
    if (grid < 0) return;
    Args a{};
    for (int i = 0; i < 28; ++i) a.in[i] = (const float*)d_in[i];
    a.out = (float*)d_out; a.ws = (unsigned char*)d_ws;
#if MK_PER_PHASE
#ifndef HOST_REP_MASK
#define HOST_REP_MASK 0
#endif
#define LAUNCH_P(p) do { a.ph_lo = (p); a.ph_hi = (p) + 1; for (int r_ = 0; r_ < (((HOST_REP_MASK >> (p)) & 1) ? 2 : 1); ++r_) hipLaunchKernelGGL(mk_fwd<(1 << (p))>, dim3(grid), dim3(512), LDS_BYTES, stream, a); } while (0)
    LAUNCH_P(0); LAUNCH_P(1); LAUNCH_P(2); LAUNCH_P(3); LAUNCH_P(4); LAUNCH_P(5); LAUNCH_P(6); LAUNCH_P(7); LAUNCH_P(8); LAUNCH_P(9); LAUNCH_P(10); LAUNCH_P(11); LAUNCH_P(12); LAUNCH_P(13); LAUNCH_P(14); LAUNCH_P(15);
#else
    a.ph_lo = 0; a.ph_hi = NPHASE;
    if (hipMemsetAsync((char*)d_ws + WS_BAR, 0, XCD_BAR_WORDS * 4, stream) != hipSuccess) { fprintf(stderr, "kernel_launch: memset of the barrier words failed\n"); return; }
    void* args[] = {&a};
    hipError_t e = hipLaunchCooperativeKernel((const void*)mk_fwd<0xffff>, dim3(grid), dim3(512), args, LDS_BYTES, stream);
    if (e != hipSuccess) fprintf(stderr, "cooperative launch failed: %s (grid %d)\n", hipGetErrorString(e), grid);
#endif
}
```

```cpp
#include <hip/hip_runtime.h>
#include <hip/hip_cooperative_groups.h>
#include <cstdio>
#include <cstdint>
namespace cg = cooperative_groups;

#ifndef MK_PER_PHASE
#define MK_PER_PHASE 0
#endif

namespace pg8 {
#define PG8_LAS __attribute__((address_space(3)))
typedef unsigned short bf16_t;
typedef short bf16x8 __attribute__((ext_vector_type(8)));
typedef float f32x4 __attribute__((ext_vector_type(4)));
typedef unsigned u32x4 __attribute__((ext_vector_type(4)));
constexpr int BM = 256, BK = 64, HALF = 128, HTB = HALF * BK * 2  , STAGE_BYTES = 8 * HTB, NXCD = 8, WGM = 8;

__host__ __device__ __forceinline__ int lds_byte(int r, int c) { const int st = (r >> 4) * 2 + (c >> 5), rr = r & 15, cc = c & 31, ob = rr * 64 + cc * 2; return st * 1024 + (ob ^ (((ob >> 9) & 1) << 5)); }
__host__ __device__ __forceinline__ void stage_rc(int b, int& R, int& C) { const int st = b / 1024, sb = b % 1024, swz = sb ^ (((sb >> 9) & 1) << 5); R = (st >> 1) * 16 + swz / 64; C = (st & 1) * 32 + (swz % 64) / 2; }
__host__ __device__ __forceinline__ int perm32(int rho) { const int n = rho >> 4, i = rho & 15; return 8 * (i >> 2) + 4 * n + (i & 3); }

struct Unit { int pm, pn; };
struct Gemm { const bf16_t* A; const bf16_t* Bt; int M, N, K; };

struct StaticOrder {
    int nM, nN, nwg, G, c;
    __host__ __device__ void init(int M, int N, int G_, int c_) { nM = M / BM; nN = N / BM; nwg = nM * nN; G = G_; c = c_; }
    __host__ __device__ bool next(int i, Unit& u) const {
        const long L = (long)i * G + c; if (L >= nwg) return false;
        int wgid = (int)L; { const int q = nwg / NXCD, r = nwg % NXCD, xcd = wgid % NXCD, off = wgid / NXCD; wgid = (xcd < r ? xcd * (q + 1) : r * (q + 1) + (xcd - r) * q) + off; }
        const int nig = WGM * nN, gid = wgid / nig, fm = gid * WGM, gsz = (nM - fm) < WGM ? (nM - fm) : WGM;
        u.pm = fm + ((wgid % nig) % gsz); u.pn = (wgid % nig) / gsz; return true;
    }
    __device__ __forceinline__ void a_ready(const Unit&) const {}
    __device__ __forceinline__ void done(const Unit&) const {}
};

typedef float f32x2_t __attribute__((ext_vector_type(2))); typedef __bf16 bf16x2_t __attribute__((ext_vector_type(2)));
__device__ __forceinline__ unsigned cvt_pk_bf16(float lo, float hi) { f32x2_t v = {lo, hi}; bf16x2_t b = __builtin_convertvector(v, bf16x2_t); return __builtin_bit_cast(unsigned, b); }
__device__ __forceinline__ float bf_lo(unsigned w) { return __uint_as_float(w << 16); }
__device__ __forceinline__ float bf_hi(unsigned w) { return __uint_as_float(w & 0xffff0000u); }
__device__ __forceinline__ float sigmoidf_(float x) { return __builtin_amdgcn_rcpf(1.0f + __expf(-x)); }

constexpr int E_MP = 65536;

template <int MODE> struct EpiB {
    static constexpr bool PERM = true, AFTER_DRAIN = false;
    bf16_t* O; int ldc; const bf16_t* G; bf16_t* O2; int zsplit; int gcol0 = 0;
    __device__ __forceinline__ void operator()(const f32x4 (&acc)[2][2][4][2], const Unit& u, int wr, int wc, int fr, int fq) const {
        const int row0 = u.pm * BM + wr * 64 + fr; int colt = u.pn * BM; bf16_t* base = O; int ld = ldc; bool sig = false;
        if (MODE == 1) { if (u.pn >= zsplit) { base = O2; ld = 2048; colt += gcol0 - zsplit * BM; sig = true; } }
        const int col0 = colt + wc * 32 + 8 * fq;
        constexpr int MB = (MODE == 3) ? 2 : 4;
#pragma unroll
        for (int ai = 0; ai < 2; ++ai)
#pragma unroll
            for (int mb = 0; mb < 4; mb += MB) {
                typedef unsigned u32x2g __attribute__((ext_vector_type(2)));
                u32x2g gq[MB][2]; u32x4 tq[MODE == 3 ? MB : 1][2];
                if (MODE == 2 || MODE == 3) {
#pragma unroll
                    for (int mm = 0; mm < MB; ++mm)
#pragma unroll
                        for (int bj = 0; bj < 2; ++bj) { const size_t row = (size_t)(row0 + ai * HALF + (mb + mm) * 16);
                            gq[mm][bj] = *(const u32x2g*)((const unsigned char*)G + ((size_t)(u.pm * 8 + (MODE == 3 ? 4 : 0) + u.pn) << 16) + ((((ai * 4 + (mb + mm)) * 2 + bj) * 8 + (wr * 4 + wc)) << 9) + ((fq * 16 + fr) << 3));
                            if (MODE == 3) tq[mm][bj] = *(const u32x4*)((const unsigned char*)O2 + ((size_t)(u.pm * 4 + u.pn) << 17) + ((((ai * 4 + (mb + mm)) * 2 + bj) * 8 + (wr * 4 + wc)) << 10) + ((fq * 16 + fr) << 4)); }
                }
#pragma unroll
                for (int mm = 0; mm < MB; ++mm) { const int m = mb + mm; const size_t row = (size_t)(row0 + ai * HALF + m * 16); bf16_t* rowp = base + row * ld + col0;
#pragma unroll
                    for (int bj = 0; bj < 2; ++bj) { f32x4 v0 = acc[ai][bj][m][0], v1 = acc[ai][bj][m][1];
                        if (MODE == 1) { if (sig) {
#pragma unroll
                            for (int j = 0; j < 4; ++j) { v0[j] = sigmoidf_(v0[j]); v1[j] = sigmoidf_(v1[j]); } } }
                        if (MODE == 2 || MODE == 3) {
                            const u32x2g g = gq[mm][bj]; const float k255 = 1.0f / 255.0f;
                            v0[0] *= (float)(g.x & 0xffu) * k255; v0[1] *= (float)((g.x >> 8) & 0xffu) * k255; v0[2] *= (float)((g.x >> 16) & 0xffu) * k255; v0[3] *= (float)(g.x >> 24) * k255;
                            v1[0] *= (float)(g.y & 0xffu) * k255; v1[1] *= (float)((g.y >> 8) & 0xffu) * k255; v1[2] *= (float)((g.y >> 16) & 0xffu) * k255; v1[3] *= (float)(g.y >> 24) * k255;
                            if (MODE == 3) { const u32x4 t = tq[mm][bj];
                                v0[0] += bf_lo(t.x); v0[1] += bf_hi(t.x); v0[2] += bf_lo(t.y); v0[3] += bf_hi(t.y);
                                v1[0] += bf_lo(t.z); v1[1] += bf_hi(t.z); v1[2] += bf_lo(t.w); v1[3] += bf_hi(t.w); }
                        }
                        if (MODE == 5) {
#pragma unroll
                            for (int j = 0; j < 4; ++j) { float a = fmaxf(v0[j], 0.f), b = fmaxf(v1[j], 0.f); v0[j] = a * a; v1[j] = b * b; } }
                        if (MODE == 1 && sig) {
                            typedef unsigned u32x2 __attribute__((ext_vector_type(2)));
                            unsigned lo = 0u, hv = 0u;
                            lo = __builtin_amdgcn_cvt_pk_u8_f32(v0[0] * 255.0f, 0, lo); lo = __builtin_amdgcn_cvt_pk_u8_f32(v0[1] * 255.0f, 1, lo); lo = __builtin_amdgcn_cvt_pk_u8_f32(v0[2] * 255.0f, 2, lo); lo = __builtin_amdgcn_cvt_pk_u8_f32(v0[3] * 255.0f, 3, lo);
                            hv = __builtin_amdgcn_cvt_pk_u8_f32(v1[0] * 255.0f, 0, hv); hv = __builtin_amdgcn_cvt_pk_u8_f32(v1[1] * 255.0f, 1, hv); hv = __builtin_amdgcn_cvt_pk_u8_f32(v1[2] * 255.0f, 2, hv); hv = __builtin_amdgcn_cvt_pk_u8_f32(v1[3] * 255.0f, 3, hv);
                            u32x2 w8; w8.x = lo; w8.y = hv;
                            const int gt_ = (gcol0 >> 8) + (u.pn - zsplit);
                            *(u32x2*)((unsigned char*)O2 + ((size_t)(u.pm * 8 + gt_) << 16) + ((((ai * 4 + m) * 2 + bj) * 8 + (wr * 4 + wc)) << 9) + ((fq * 16 + fr) << 3)) = w8;
                        } else {
                        u32x4 w; w.x = cvt_pk_bf16(v0[0], v0[1]); w.y = cvt_pk_bf16(v0[2], v0[3]); w.z = cvt_pk_bf16(v1[0], v1[1]); w.w = cvt_pk_bf16(v1[2], v1[3]);
                        if (MODE == 2) *(u32x4*)((unsigned char*)O2 + ((size_t)(u.pm * 4 + u.pn) << 17) + ((((ai * 4 + m) * 2 + bj) * 8 + (wr * 4 + wc)) << 10) + ((fq * 16 + fr) << 4)) = w;
                        else *(u32x4*)(rowp + bj * HALF) = w; } } }
                if (MODE == 2 || MODE == 3) asm volatile("" ::: "memory");
            }
    }
};
struct EpiH {
    static constexpr bool PERM = true, AFTER_DRAIN = false;
    const float* xp; const float* xs; bf16_t* H; const float* gate;
    __device__ __forceinline__ void operator()(const f32x4 (&acc)[2][2][4][2], const Unit& u, int wr, int wc, int fr, int fq) const {
        const int rowt = u.pm * BM; const int modrow = rowt < E_MP ? (rowt >> 13) : 8 + ((rowt - E_MP) >> 12);
        const float* gt = gate + (size_t)modrow * 6144;
        const float* src = rowt < E_MP ? xp : xs - (size_t)E_MP * 1024;
        const int row0 = rowt + wr * 64 + fr, col0 = u.pn * BM + wc * 32 + 8 * fq;
        f32x4 gv[2][2];
#pragma unroll
        for (int bj = 0; bj < 2; ++bj)
#pragma unroll
            for (int n = 0; n < 2; ++n) gv[bj][n] = *(const f32x4*)(gt + col0 + bj * HALF + 4 * n);
#pragma unroll
        for (int ai = 0; ai < 2; ++ai)
#pragma unroll
            for (int mb = 0; mb < 4; mb += 2) {
                f32x4 sq[2][2][2];
#pragma unroll
                for (int mm = 0; mm < 2; ++mm)
#pragma unroll
                    for (int bj = 0; bj < 2; ++bj)
#pragma unroll
                        for (int n = 0; n < 2; ++n) sq[mm][bj][n] = *(const f32x4*)(src + (size_t)(row0 + ai * HALF + (mb + mm) * 16) * 1024 + col0 + bj * HALF + 4 * n);
#pragma unroll
                for (int mm = 0; mm < 2; ++mm)
#pragma unroll
                    for (int bj = 0; bj < 2; ++bj) { const f32x4 v0 = sq[mm][bj][0] + gv[bj][0] * acc[ai][bj][mb + mm][0], v1 = sq[mm][bj][1] + gv[bj][1] * acc[ai][bj][mb + mm][1];
                        u32x4 w; w.x = cvt_pk_bf16(v0[0], v0[1]); w.y = cvt_pk_bf16(v0[2], v0[3]); w.z = cvt_pk_bf16(v1[0], v1[1]); w.w = cvt_pk_bf16(v1[2], v1[3]);
                        *(u32x4*)(H + (size_t)(row0 + ai * HALF + (mb + mm) * 16) * 1024 + col0 + bj * HALF) = w; }
                asm volatile("" ::: "memory");
            }
    }
};
struct EpiF {
    static constexpr bool PERM = false, AFTER_DRAIN = false;
    const bf16_t* H; float* out; const float* gate; int row_off;
    __device__ __forceinline__ void operator()(const f32x4 (&acc)[2][2][4][2], const Unit& u, int wr, int wc, int fr, int fq) const {
        typedef unsigned u32x2 __attribute__((ext_vector_type(2)));
        const int rowt = row_off + u.pm * BM; const int modrow = rowt < E_MP ? (rowt >> 13) : 8 + ((rowt - E_MP) >> 12);
        const float* gt = gate + (size_t)modrow * 6144;
        const int row0 = rowt + wr * 64 + fr, col0 = u.pn * BM + wc * 32 + 4 * fq;
        f32x4 gv[2][2];
#pragma unroll
        for (int bj = 0; bj < 2; ++bj)
#pragma unroll
            for (int n = 0; n < 2; ++n) gv[bj][n] = *(const f32x4*)(gt + col0 + bj * HALF + n * 16);
#pragma unroll
        for (int ai = 0; ai < 2; ++ai) {
            u32x2 hq[4][2][2];
#pragma unroll
            for (int m = 0; m < 4; ++m)
#pragma unroll
                for (int bj = 0; bj < 2; ++bj)
#pragma unroll
                    for (int n = 0; n < 2; ++n) hq[m][bj][n] = *(const u32x2*)(H + (size_t)(row0 + ai * HALF + m * 16) * 1024 + col0 + bj * HALF + n * 16);
#pragma unroll
            for (int m = 0; m < 4; ++m)
#pragma unroll
                for (int bj = 0; bj < 2; ++bj)
#pragma unroll
                    for (int n = 0; n < 2; ++n) { const u32x2 h = hq[m][bj][n]; f32x4 hv; hv[0] = bf_lo(h.x); hv[1] = bf_hi(h.x); hv[2] = bf_lo(h.y); hv[3] = bf_hi(h.y);
                        *(f32x4*)(out + (size_t)(row0 + ai * HALF + m * 16) * 1024 + col0 + bj * HALF + n * 16) = hv + gv[bj][n] * acc[ai][bj][m][n]; }
            asm volatile("" ::: "memory");
        }
    }
};

template <class Epi, class Sched, bool ALIGN_EPI = false, bool SP2 = false>
__device__ __forceinline__ void gemm_phase(PG8_LAS unsigned char* lds, const Gemm g, const Sched& S, const Epi& E) {
    const int tid = threadIdx.x, wid = __builtin_amdgcn_readfirstlane(tid >> 6), lane = tid & 63, wr = wid >> 2, wc = wid & 3, fr = lane & 15, fq = lane >> 4;
    const int K = g.K, nt = K / BK;
    unsigned voffA[2], voffB[2];
#pragma unroll
    for (int i = 0; i < 2; ++i) { int R, C; stage_rc(tid * 16 + i * 8192, R, C); const int Rb = Epi::PERM ? ((R & ~31) + perm32(R & 31)) : R;
        voffA[i] = (unsigned)(R * K + C) * 2u; voffB[i] = (unsigned)(Rb * K + C) * 2u; }
    const size_t kstep = (size_t)(BK * 2);
    const size_t hstep = (size_t)HALF * K * 2;
    const size_t tstep = 2 * hstep;
    const unsigned ldsw = (unsigned)wid * 1024u;
    const int aoff = lds_byte(wr * 64 + fr, fq * 8), boff = lds_byte(wc * 32 + fr, fq * 8);
#define PG8_SA(b, h) (((b) * 2 + (h)) * HTB)
#define PG8_SB(b, h) ((4 + (b) * 2 + (h)) * HTB)
#define PG8_STAGE(bufoff, gbase, voff) do { _Pragma("unroll") for (int _i = 0; _i < 2; ++_i) \
        __builtin_amdgcn_global_load_lds((const unsigned*)((const char*)(gbase) + (voff)[_i]), (PG8_LAS unsigned*)(lds + (bufoff) + ldsw + _i * 8192), 16, 0, 0); } while (0)
#define PG8_LDA(dst, b, h) do { _Pragma("unroll") for (int m = 0; m < 4; ++m) _Pragma("unroll") for (int k = 0; k < 2; ++k) dst[m][k] = *(const PG8_LAS bf16x8*)(lds + PG8_SA(b, h) + aoff + m * 2048 + k * 1024); } while (0)
#define PG8_LDB(dst, b, h) do { _Pragma("unroll") for (int n = 0; n < 2; ++n) _Pragma("unroll") for (int k = 0; k < 2; ++k) dst[n][k] = *(const PG8_LAS bf16x8*)(lds + PG8_SB(b, h) + boff + n * 2048 + k * 1024); } while (0)
#define PG8_MMA(ai, bj, At, Bt) do { __builtin_amdgcn_s_setprio(1); _Pragma("unroll") for (int m = 0; m < 4; ++m) _Pragma("unroll") for (int n = 0; n < 2; ++n) _Pragma("unroll") for (int k = 0; k < 2; ++k) \
        acc[ai][bj][m][n] = __builtin_amdgcn_mfma_f32_16x16x32_bf16(Bt[n][k], At[m][k], acc[ai][bj][m][n], 0, 0, 0); __builtin_amdgcn_s_setprio(0); } while (0)
#define PG8_WAIT_V(n) asm volatile("s_waitcnt vmcnt(" #n ")" ::: "memory")
#define PG8_WAIT_L(n) asm volatile("s_waitcnt lgkmcnt(" #n ")" ::: "memory")
#define PG8_BAR __builtin_amdgcn_s_barrier()
#define PG8_SCHED __builtin_amdgcn_sched_barrier(0)
    Unit cur, nxt; int ui = 0;
    if (!S.next(0, cur)) return;
    f32x4 acc[2][2][4][2];
#pragma unroll
    for (int a = 0; a < 2; ++a)
#pragma unroll
        for (int b = 0; b < 2; ++b)
#pragma unroll
            for (int m = 0; m < 4; ++m)
#pragma unroll
                for (int n = 0; n < 2; ++n) acc[a][b][m][n] = (f32x4){0.f, 0.f, 0.f, 0.f};
    bf16x8 At[4][2], B0[2][2], B1[2][2];
    const char* cA = (const char*)g.A + (size_t)cur.pm * tstep; const char* cB = (const char*)g.Bt + (size_t)cur.pn * tstep;
    S.a_ready(cur);
    if constexpr (SP2) {
        PG8_STAGE(PG8_SB(0, 0), cB, voffB); PG8_STAGE(PG8_SB(0, 1), cB + hstep, voffB); PG8_STAGE(PG8_SA(0, 0), cA, voffA); PG8_STAGE(PG8_SA(0, 1), cA + hstep, voffA);
        if (wr == 1) PG8_BAR;
        PG8_WAIT_V(2); PG8_BAR;
        PG8_STAGE(PG8_SB(1, 0), cB + kstep, voffB); PG8_STAGE(PG8_SA(1, 0), cA + kstep, voffA); PG8_STAGE(PG8_SB(1, 1), cB + hstep + kstep, voffB);
        PG8_WAIT_V(6); PG8_BAR;
    } else {
        PG8_STAGE(PG8_SB(0, 0), cB, voffB); PG8_STAGE(PG8_SA(0, 0), cA, voffA); PG8_STAGE(PG8_SB(0, 1), cB + hstep, voffB); PG8_STAGE(PG8_SA(0, 1), cA + hstep, voffA);
        if (wr == 1) PG8_BAR;
        PG8_WAIT_V(4); PG8_BAR;
        PG8_STAGE(PG8_SB(1, 0), cB + kstep, voffB); PG8_STAGE(PG8_SA(1, 0), cA + kstep, voffA); PG8_STAGE(PG8_SB(1, 1), cB + hstep + kstep, voffB);
        PG8_WAIT_V(6); PG8_BAR;
    }
    for (;;) {
        const bool has_next = S.next(ui + 1, nxt);
        const char* nA = has_next ? (const char*)g.A + (size_t)nxt.pm * tstep : cA; const char* nB = has_next ? (const char*)g.Bt + (size_t)nxt.pn * tstep : cB;
        for (int t = 0; t < nt; t += 2) {
            const bool last = (t == nt - 2);
            const char* a1 = cA + (size_t)(t + 1) * kstep;
            const char* a2 = last ? nA : cA + (size_t)(t + 2) * kstep; const char* b2 = last ? nB : cB + (size_t)(t + 2) * kstep;
            const char* a3 = a2 + kstep; const char* b3 = b2 + kstep;
            if (last && has_next) S.a_ready(nxt);
            if constexpr (SP2) {
            PG8_LDB(B0, 0, 0); PG8_LDB(B1, 0, 1); PG8_SCHED; PG8_LDA(At, 0, 0); PG8_STAGE(PG8_SA(1, 1), a1 + hstep, voffA);
            PG8_WAIT_V(8); PG8_WAIT_L(0); PG8_BAR; PG8_MMA(0, 0, At, B0); PG8_MMA(0, 1, At, B1); PG8_BAR; PG8_SCHED;
            PG8_LDA(At, 0, 1); PG8_STAGE(PG8_SB(0, 0), b2, voffB); PG8_STAGE(PG8_SB(0, 1), b2 + hstep, voffB); PG8_STAGE(PG8_SA(0, 0), a2, voffA);
            PG8_WAIT_V(8); PG8_WAIT_L(0); PG8_BAR; PG8_MMA(1, 0, At, B0); PG8_MMA(1, 1, At, B1); PG8_BAR; PG8_SCHED;
            PG8_LDB(B0, 1, 0); PG8_LDB(B1, 1, 1); PG8_SCHED; PG8_LDA(At, 1, 0); PG8_STAGE(PG8_SA(0, 1), a2 + hstep, voffA);
            PG8_WAIT_V(8); PG8_WAIT_L(0); PG8_BAR; PG8_MMA(0, 0, At, B0); PG8_MMA(0, 1, At, B1); PG8_BAR; PG8_SCHED;
            PG8_LDA(At, 1, 1); PG8_STAGE(PG8_SB(1, 0), b3, voffB); PG8_STAGE(PG8_SB(1, 1), b3 + hstep, voffB); PG8_STAGE(PG8_SA(1, 0), a3, voffA);
            PG8_WAIT_V(8); PG8_WAIT_L(0); PG8_BAR; PG8_MMA(1, 0, At, B0); PG8_MMA(1, 1, At, B1); PG8_BAR; PG8_SCHED;
            } else {
            PG8_LDB(B0, 0, 0); PG8_SCHED; PG8_LDA(At, 0, 0); PG8_STAGE(PG8_SA(1, 1), a1 + hstep, voffA);
            PG8_WAIT_L(8); PG8_BAR; PG8_WAIT_L(0); PG8_MMA(0, 0, At, B0); PG8_BAR; PG8_SCHED;
            PG8_LDB(B1, 0, 1); PG8_STAGE(PG8_SB(0, 0), b2, voffB);
            PG8_BAR; PG8_WAIT_L(0); PG8_MMA(0, 1, At, B1); PG8_BAR;
            PG8_LDA(At, 0, 1); PG8_STAGE(PG8_SA(0, 0), a2, voffA);
            PG8_BAR; PG8_WAIT_L(0); PG8_MMA(1, 0, At, B0); PG8_BAR; PG8_SCHED;
            PG8_STAGE(PG8_SB(0, 1), b2 + hstep, voffB);
            PG8_WAIT_V(6); PG8_BAR; PG8_MMA(1, 1, At, B1); PG8_BAR;
            PG8_LDB(B0, 1, 0); PG8_SCHED; PG8_LDA(At, 1, 0); PG8_STAGE(PG8_SA(0, 1), a2 + hstep, voffA);
            PG8_WAIT_L(8); PG8_BAR; PG8_WAIT_L(0); PG8_MMA(0, 0, At, B0); PG8_BAR; PG8_SCHED;
            PG8_LDB(B1, 1, 1); PG8_STAGE(PG8_SB(1, 0), b3, voffB);
            PG8_BAR; PG8_WAIT_L(0); PG8_MMA(0, 1, At, B1); PG8_BAR;
            PG8_LDA(At, 1, 1); PG8_STAGE(PG8_SA(1, 0), a3, voffA);
            PG8_BAR; PG8_WAIT_L(0); PG8_MMA(1, 0, At, B0); PG8_BAR; PG8_SCHED;
            PG8_STAGE(PG8_SB(1, 1), b3 + hstep, voffB);
            PG8_WAIT_V(6); PG8_BAR; PG8_MMA(1, 1, At, B1); PG8_BAR;
            }
        }
        if constexpr (ALIGN_EPI) { if (wr == 0) PG8_BAR; }
        if constexpr (!Epi::AFTER_DRAIN) { E(acc, cur, wr, wc, fr, fq); S.done(cur); }
        if (!has_next) break;
#pragma unroll
        for (int a = 0; a < 2; ++a)
#pragma unroll
            for (int b = 0; b < 2; ++b)
#pragma unroll
                for (int m = 0; m < 4; ++m)
#pragma unroll
                    for (int n = 0; n < 2; ++n) acc[a][b][m][n] = (f32x4){0.f, 0.f, 0.f, 0.f};
        cur = nxt; cA = nA; cB = nB; ++ui;
        if constexpr (ALIGN_EPI) { if (wr == 1) PG8_BAR; }
    }
    PG8_WAIT_V(0);
    if constexpr (!ALIGN_EPI) { if (wr == 0) PG8_BAR; }
    PG8_BAR;
    if constexpr (Epi::AFTER_DRAIN) { E.fused(acc, cur, wr, wc, fr, fq, lds, wid, lane); S.done(cur); }
#undef PG8_SA
#undef PG8_SB
#undef PG8_STAGE
#undef PG8_LDA
#undef PG8_LDB
#undef PG8_MMA
#undef PG8_WAIT_V
#undef PG8_WAIT_L
#undef PG8_BAR
#undef PG8_SCHED
}
}

constexpr int DM = 1024, LP = 8192, LS = 4096, NB = 8;
constexpr int MP = NB * LP, MS = NB * LS, MT = MP + MS;
constexpr int DH = 768, ZW = 2304, QW = 2304, GW = 2048, DFF = 4096, NIN = 6656;
constexpr float RMS_EPS = 1e-6f;
static_assert(MP == pg8::E_MP, "row split");
constexpr size_t MiB = 1u << 20;
constexpr size_t WS_MOD = 0, WS_H3 = 1 * MiB, WS_BAR = 4 * MiB;
constexpr size_t WS_WIN = 8 * MiB, WS_WHB = 21 * MiB, WS_WAB = 23 * MiB, WS_WOUT = 24 * MiB, WS_WUP = 26 * MiB, WS_WDN = 34 * MiB;
constexpr size_t WS_U1 = 48 * MiB, WS_KSPEC = 48 * MiB, WS_T1 = 48 * MiB;
constexpr size_t WS_T1L = 240 * MiB;
constexpr size_t WS_H16 = 240 * MiB, WS_FF = 432 * MiB;
constexpr size_t WS_QKV = 240 * MiB, WS_ZHY = 240 * MiB;
constexpr size_t WS_OG = 672 * MiB, WS_UCT = 672 * MiB;
constexpr size_t WS_LSE = 816 * MiB, WS_YH = 816 * MiB, WS_U2 = 816 * MiB;
constexpr size_t WS_YAT = 960 * MiB, WS_END = 1008 * MiB;
constexpr size_t WS_KRAW = 880 * MiB;
constexpr int LDS_BYTES = 147456;
constexpr int NPHASE = 16;

#define LAS __attribute__((address_space(3)))
typedef unsigned short bf16;
typedef unsigned v4u __attribute__((ext_vector_type(4)));
typedef unsigned v2u __attribute__((ext_vector_type(2)));
typedef float f32x4 __attribute__((ext_vector_type(4)));
typedef short bf16x8 __attribute__((ext_vector_type(8)));
typedef float f32x16 __attribute__((ext_vector_type(16)));
#define LDS_WAIT() asm volatile("s_waitcnt lgkmcnt(0)" ::: "memory")
__device__ __forceinline__ float bf2f(unsigned short h) { return __uint_as_float((unsigned)h << 16); }
__device__ __forceinline__ unsigned pk2(float lo, float hi) { return pg8::cvt_pk_bf16(lo, hi); }
__device__ __forceinline__ float wave_sum(float v) {
#pragma unroll
    for (int o = 1; o < 64; o <<= 1) v += __shfl_xor(v, o);
    return v;
}

#define FFT_DI __device__ __forceinline__
#define FFT_ASM 1
#define FFT_SINCOSPI(x, s, c) do { const float h_ = 0.5f * (x); (s) = __builtin_amdgcn_sinf(h_); (c) = __builtin_amdgcn_cosf(h_); } while (0)
__device__ __forceinline__ int lnd(int x) { asm volatile("" : "+v"(x)); return x; }
#define FFT_LND(x) lnd(x)
#define FFT_SCHED() __builtin_amdgcn_sched_barrier(0)
#ifndef GEMM_SP2
#define GEMM_SP2 true
#endif
#define FFT_TRANS_FENCE(a, b) asm volatile("s_nop 1" : "+v"(a), "+v"(b))
#ifndef GEMM_ALIGN
#define GEMM_ALIGN true
#endif
typedef float cf2 __attribute__((ext_vector_type(2)));
#ifdef FFT_ASM
FFT_DI cf2 cmul_conjw(cf2 d, cf2 W) { cf2 t, o; asm("v_pk_mul_f32 %0, %1, %2 op_sel_hi:[1,0]" : "=v"(t) : "v"(d), "v"(W));
    asm("v_pk_fma_f32 %0, %1, %2, %3 op_sel:[1,1,0] op_sel_hi:[0,1,1] neg_hi:[1,0,0]" : "=v"(o) : "v"(d), "v"(W), "v"(t)); return o; }
FFT_DI cf2 cmul_w(cf2 b, cf2 W) { cf2 t, o; asm("v_pk_mul_f32 %0, %1, %2 op_sel_hi:[1,0]" : "=v"(t) : "v"(b), "v"(W));
    asm("v_pk_fma_f32 %0, %1, %2, %3 op_sel:[1,1,0] op_sel_hi:[0,1,1] neg_lo:[1,0,0]" : "=v"(o) : "v"(b), "v"(W), "v"(t)); return o; }
#else
FFT_DI cf2 cmul_conjw(cf2 d, cf2 W) { cf2 dr; dr.x = d.y; dr.y = -d.x; return d * __builtin_shufflevector(W, W, 0, 0) + dr * __builtin_shufflevector(W, W, 1, 1); }
FFT_DI cf2 cmul_w(cf2 b, cf2 W) { cf2 br; br.x = -b.y; br.y = b.x; return b * __builtin_shufflevector(W, W, 0, 0) + br * __builtin_shufflevector(W, W, 1, 1); }
#endif
FFT_DI cf2 cmul(cf2 a, cf2 b) { return cmul_w(a, b); }
#define FFT_C32(j) ((j) == 0 ? 1.0f : (j) == 1 ? 0.98078528040323043f : (j) == 2 ? 0.92387953251128674f : (j) == 3 ? 0.83146961230254524f : (j) == 4 ? 0.70710678118654752f : (j) == 5 ? 0.55557023301960218f : (j) == 6 ? 0.38268343236508977f : (j) == 7 ? 0.19509032201612825f : (j) == 8 ? 0.0f : (j) == 9 ? -0.19509032201612825f : (j) == 10 ? -0.38268343236508977f : (j) == 11 ? -0.55557023301960218f : (j) == 12 ? -0.70710678118654752f : (j) == 13 ? -0.83146961230254524f : (j) == 14 ? -0.92387953251128674f : -0.98078528040323043f)
FFT_DI constexpr float fft_cos32(int j) { return FFT_C32(j); }
FFT_DI constexpr float fft_sin32(int j) { return FFT_C32((j) >= 8 ? (j) - 8 : 8 - (j)); }

template <int Q, bool Z>
FFT_DI void fft_twiddles(cf2 (&Wm)[16], int i0low, int slog) {
    constexpr int q = Q;
    if (Z) {
#pragma unroll
        for (int m = 0; m < (1 << q); ++m) { Wm[m].x = fft_cos32(m << (4 - q)); Wm[m].y = fft_sin32(m << (4 - q)); }
    } else {
        float sb, cb; FFT_SINCOSPI((float)FFT_LND(i0low) * (1.0f / (float)(1 << (slog + q))), sb, cb);
        FFT_TRANS_FENCE(sb, cb);
        Wm[0].x = cb; Wm[0].y = sb;
        cf2 R; R.x = fft_cos32(1 << (4 - q)); R.y = fft_sin32(1 << (4 - q));
#pragma unroll
        for (int m = 1; m < (1 << q); ++m) Wm[m] = cmul_w(Wm[m - 1], R);
    }
}
template <int K, int OFF, int Q, bool Z>
FFT_DI void dif_stage(cf2 (&v)[32], int i0low, int slog) {
    constexpr int q = Q;
    cf2 Wm[16]; fft_twiddles<Q, Z>(Wm, i0low, slog);
#pragma unroll
    for (int e = 0; e < (1 << K); ++e) if (!(e & (1 << q))) {
        const int m = e & ((1 << q) - 1);
        const cf2 a = v[OFF + e], b = v[OFF + e + (1 << q)];
        v[OFF + e] = a + b;
        const cf2 d = a - b;
        if (Z && m == 0) v[OFF + e + (1 << q)] = d; else v[OFF + e + (1 << q)] = cmul_conjw(d, Wm[m]);
    }
}
template <int K, int OFF, bool Z = false>
FFT_DI void dif_stages(cf2 (&v)[32], int i0low, int slog) {
    if constexpr (K >= 5) dif_stage<K, OFF, 4, Z>(v, i0low, slog);
    dif_stage<K, OFF, 3, Z>(v, i0low, slog); dif_stage<K, OFF, 2, Z>(v, i0low, slog); dif_stage<K, OFF, 1, Z>(v, i0low, slog); dif_stage<K, OFF, 0, Z>(v, i0low, slog);
}
template <int K, int OFF, int Q, bool Z>
FFT_DI void dit_stage(cf2 (&v)[32], int i0low, int slog) {
    constexpr int q = Q;
    cf2 Wm[16]; fft_twiddles<Q, Z>(Wm, i0low, slog);
#pragma unroll
    for (int e = 0; e < (1 << K); ++e) if (!(e & (1 << q))) {
        const int m = e & ((1 << q) - 1);
        const cf2 a = v[OFF + e], b0 = v[OFF + e + (1 << q)];
        cf2 bw; if (Z && m == 0) bw = b0; else bw = cmul_w(b0, Wm[m]);
        v[OFF + e] = a + bw; v[OFF + e + (1 << q)] = a - bw;
    }
}
template <int K, int OFF, bool Z = false>
FFT_DI void dit_stages(cf2 (&v)[32], int i0low, int slog) {
    dit_stage<K, OFF, 0, Z>(v, i0low, slog); dit_stage<K, OFF, 1, Z>(v, i0low, slog); dit_stage<K, OFF, 2, Z>(v, i0low, slog); dit_stage<K, OFF, 3, Z>(v, i0low, slog);
    if constexpr (K >= 5) dit_stage<K, OFF, 4, Z>(v, i0low, slog);
}
FFT_DI int fft_swz(int i) { return i ^ ((i >> 5) & 31); }
FFT_DI int fft_idxA(int tid, int e) { return tid + 512 * e; }
FFT_DI int fft_idxB(int tid, int e) { return ((tid >> 4) << 9) + (tid & 15) + 16 * e; }
FFT_DI int fft_idxC(int tid, int e) { return 32 * tid + e; }

struct Args { const float* in[28]; float* out; unsigned char* ws; int ph_lo, ph_hi; };
enum { I_XP = 0, I_XS, I_CP, I_CS, I_RELB, I_ADAW, I_ADAB, I_N1G, I_WIN, I_CONVW, I_CONVB, I_FW1, I_FB1, I_FW2, I_FB2, I_FW3, I_FB3, I_FFREQ, I_FWOUT,
       I_HYD, I_QNG, I_KNG, I_WHB, I_WAB, I_WOUT, I_N2G, I_WUP, I_WDN };

__device__ __forceinline__ void p0_transpose_item(const float* W, int K, int N, bf16* WT, int row_off, LAS float* scr, int item, int lane) {
    const int nblk = N / 32, kb = item / nblk, nb = item % nblk, k0 = 64 * kb, n0 = 32 * nb;
#pragma unroll 8
    for (int i = 0; i < 32; ++i) { const int kk = 2 * i + (lane >> 5); scr[kk * 33 + (lane & 31)] = W[(size_t)(k0 + kk) * N + n0 + (lane & 31)]; }
    LDS_WAIT();
    const int c = lane & 7;
#pragma unroll
    for (int j = 0; j < 4; ++j) { const int n = (lane >> 3) + 8 * j; const LAS float* s = scr + (8 * c) * 33 + n;
        v4u o; o.x = pk2(s[0 * 33], s[1 * 33]); o.y = pk2(s[2 * 33], s[3 * 33]); o.z = pk2(s[4 * 33], s[5 * 33]); o.w = pk2(s[6 * 33], s[7 * 33]);
        *(v4u*)(WT + (size_t)(row_off + n0 + n) * K + k0 + 8 * c) = o; }
    LDS_WAIT();
}

__device__ __forceinline__ void p0_mod(const Args& a, LAS unsigned char* lds, int bid, int G, int tid) {
    LAS float* S = (LAS float*)lds;
    LAS float* P = (LAS float*)(lds + 65536);
    const int wave = tid >> 6, lane = tid & 63;
    float* MOD = (float*)(a.ws + WS_MOD);
    for (int cb = bid; cb < 96; cb += G) {
        for (int idx = tid; idx < 16384; idx += 512) { const int r = idx >> 10, k = idx & 1023;
            const float c = r < 8 ? a.in[I_CP][r * 1024 + k] : a.in[I_CS][(r - 8) * 1024 + k];
            S[k * 16 + r] = c / (1.0f + __expf(-c)); }
        __syncthreads();
        float acc[16];
#pragma unroll
        for (int r = 0; r < 16; ++r) acc[r] = 0.f;
        const float* wp = a.in[I_ADAW] + cb * 64 + lane;
#pragma unroll 4
        for (int k = wave * 128; k < wave * 128 + 128; ++k) {
            const float wv = wp[(size_t)k * 6144];
#pragma unroll
            for (int r4 = 0; r4 < 4; ++r4) { const f32x4 s = *(const LAS f32x4*)(S + k * 16 + r4 * 4);
                acc[r4 * 4 + 0] += s.x * wv; acc[r4 * 4 + 1] += s.y * wv; acc[r4 * 4 + 2] += s.z * wv; acc[r4 * 4 + 3] += s.w * wv; }
        }
#pragma unroll
        for (int r = 0; r < 16; ++r) P[(wave * 16 + r) * 64 + lane] = acc[r];
        __syncthreads();
        for (int o = tid; o < 1024; o += 512) { const int r = o >> 6, col = o & 63; float s = a.in[I_ADAB][cb * 64 + col];
#pragma unroll
            for (int w = 0; w < 8; ++w) s += P[(w * 16 + r) * 64 + col];
            MOD[r * 6144 + cb * 64 + col] = s; }
        __syncthreads();
    }
}

__device__ __forceinline__ void p0_h3(const Args& a, int gw, int NGW, int lane) {
    float* H3 = (float*)(a.ws + WS_H3);
    const float fr = a.in[I_FFREQ][lane];
    const float b1 = a.in[I_FB1][lane], b2 = a.in[I_FB2][lane], b3 = a.in[I_FB3][lane];
    for (int p = gw; p < LP + LS; p += NGW) {
        const int grp = p >= LP, t = p - grp * LP, L = grp ? LS : LP;
        const float tt = (float)t * (1.0f / (float)(L - 1));
        const float w = 6.2831853071795864769f * (float)t / (float)L;
        float feat = 0.f;
        if (lane == 0) feat = tt;
        else if (lane <= 32) { const int bi = (lane - 1) & 15; const float band = 1e-4f + (float)bi * ((15.0f - 1e-4f) / 15.0f); const float ang = band * w;
            feat = lane <= 16 ? cosf(ang) : -sinf(ang); }
        float acc = b1;
        for (int i = 0; i < 33; ++i) acc += __shfl(feat, i) * a.in[I_FW1][i * 64 + lane];
        float h = sinf(fr * acc);
        acc = b2;
        for (int i = 0; i < 64; ++i) acc += __shfl(h, i) * a.in[I_FW2][i * 64 + lane];
        h = sinf(fr * acc);
        acc = b3;
        for (int i = 0; i < 64; ++i) acc += __shfl(h, i) * a.in[I_FW3][i * 64 + lane];
        h = sinf(fr * acc);
        H3[(size_t)p * 64 + lane] = h;
    }
}

template <bool BF> __device__ __forceinline__ void prep_rows(const float* xp, const float* xs, const bf16* hb, const float* g, const float* MOD, int shoff, int scoff, bf16* U, int gw, int NGW, int lane) {
    constexpr int R = 4;
    for (int mb = gw; mb < MT; mb += R * NGW) {
        f32x4 v[R][4]; float s[R];
#pragma unroll
        for (int r = 0; r < R; ++r) { const int m = mb + r * NGW; const int mc = m < MT ? m : mb;
#pragma unroll
            for (int j = 0; j < 4; ++j) {
                if (BF) { const v2u a0 = *(const v2u*)(hb + (size_t)mc * DM + 4 * lane + 256 * j);
                    v[r][j].x = pg8::bf_lo(a0.x); v[r][j].y = pg8::bf_hi(a0.x); v[r][j].z = pg8::bf_lo(a0.y); v[r][j].w = pg8::bf_hi(a0.y); }
                else { const float* xr = mc < MP ? xp + (size_t)mc * DM : xs + (size_t)(mc - MP) * DM; v[r][j] = *(const f32x4*)(xr + 4 * lane + 256 * j); } } }
#pragma unroll
        for (int r = 0; r < R; ++r) { float t = 0.f;
#pragma unroll
            for (int j = 0; j < 4; ++j) t += (v[r][j].x * v[r][j].x + v[r][j].y * v[r][j].y) + (v[r][j].z * v[r][j].z + v[r][j].w * v[r][j].w);
            s[r] = t; }
#pragma unroll
        for (int o = 1; o < 64; o <<= 1) {
#pragma unroll
            for (int r = 0; r < R; ++r) s[r] += __shfl_xor(s[r], o); }
#pragma unroll
        for (int r = 0; r < R; ++r) { const int m = mb + r * NGW; if (m < MT) {
            const float rstd = 1.0f / sqrtf(s[r] * (1.0f / DM) + RMS_EPS);
            const float* mr = MOD + (size_t)(m < MP ? (m >> 13) : 8 + ((m - MP) >> 12)) * 6144;
#pragma unroll
            for (int j = 0; j < 4; ++j) { const int c = 4 * lane + 256 * j;
                const f32x4 gg = *(const f32x4*)(g + c), sc = *(const f32x4*)(mr + scoff + c), sh = *(const f32x4*)(mr + shoff + c);
                const f32x4 o = v[r][j] * rstd * gg * (sc + 1.0f) + sh; v2u w; w.x = pk2(o.x, o.y); w.y = pk2(o.z, o.w); *(v2u*)(U + (size_t)m * DM + c) = w; } } }
    }
}

#define MFMA32(a, b, c) __builtin_amdgcn_mfma_f32_32x32x16_bf16((a), (b), (c), 0, 0, 0)
__device__ __forceinline__ int crow(int r, int hi) { return (r & 3) + 8 * (r >> 2) + 4 * hi; }
__device__ __forceinline__ int t5_bucket_dev(int rel) {
    const int n = rel < 0 ? -rel : rel; const int ret = rel > 0 ? 16 : 0;
    int large = 8 + (int)(logf((float)(n > 1 ? n : 1) / 8.0f) / 4.852030263919617f * 8.0f);
    large = large < 15 ? large : 15;
    return ret + (n < 8 ? n : large);
}
__device__ __forceinline__ void load_raw(const bf16* p, v4u (&raw)[4]) {
#pragma unroll
    for (int kk = 0; kk < 4; ++kk) raw[kk] = *(const v4u*)(p + 16 * kk);
}
__device__ __forceinline__ void norm_frag(const v4u (&raw)[4], const float* gain, float mul, int hi, bool valid, bf16x8 (&f)[4]) {
    float ss = 0.f;
#pragma unroll
    for (int kk = 0; kk < 4; ++kk)
#pragma unroll
        for (int w = 0; w < 4; ++w) { const unsigned u = raw[kk][w]; const float lo = pg8::bf_lo(u), hv = pg8::bf_hi(u); ss += lo * lo + hv * hv; }
    ss += __shfl_xor(ss, 32);
    const float rstd = (valid ? mul : 0.f) / sqrtf(ss * (1.0f / 64.0f) + RMS_EPS);
#pragma unroll
    for (int kk = 0; kk < 4; ++kk) { const f32x4 g0 = *(const f32x4*)(gain + 8 * hi + 16 * kk) * rstd, g1 = *(const f32x4*)(gain + 8 * hi + 16 * kk + 4) * rstd;
        const v4u r4 = raw[kk];
        v4u o; o.x = pk2(pg8::bf_lo(r4.x) * g0.x, pg8::bf_hi(r4.x) * g0.y); o.y = pk2(pg8::bf_lo(r4.y) * g0.z, pg8::bf_hi(r4.y) * g0.w);
        o.z = pk2(pg8::bf_lo(r4.z) * g1.x, pg8::bf_hi(r4.z) * g1.y); o.w = pk2(pg8::bf_lo(r4.w) * g1.z, pg8::bf_hi(r4.w) * g1.w);
        f[kk] = __builtin_bit_cast(bf16x8, o); }
}
typedef short v4i16_t __attribute__((ext_vector_type(4)));
constexpr int ATT_PITCH = 144;
constexpr int ATT_BTW = 192;
constexpr int ATT_KOFF = 12 * ATT_BTW * 4, ATT_VOFF = ATT_KOFF + 384 * ATT_PITCH;
__device__ __forceinline__ void attn_phase(const Args& a, LAS unsigned char* lds, int bid, int G, int tid) {
    const int wave = tid >> 6, lane = tid & 63, ql = lane & 31, hi = lane >> 5;
    LAS float* BT = (LAS float*)lds;
    LAS unsigned char* Ks = lds + ATT_KOFF; LAS unsigned char* Vs = lds + ATT_VOFF;
    for (int idx = tid; idx < 12 * ATT_BTW; idx += 512) { const int h = idx / ATT_BTW, rel = idx % ATT_BTW - 95, g = h >> 2;
        BT[idx] = (rel >= -64 && rel <= 64) ? a.in[I_RELB][t5_bucket_dev(rel << (2 * g)) * 12 + h] * 1.4426950408889634f : -1.0e30f; }
    __syncthreads();
    const bf16* QKV = (const bf16*)(a.ws + WS_QKV);
    bf16* OG = (bf16*)(a.ws + WS_OG); float* LSE = (float*)(a.ws + WS_LSE);
    const int i16 = lane & 15, trq = i16 >> 2, trp = i16 & 3, blk = (lane >> 4) & 1;
    const int troff = (32 * wave + 4 * hi + trq) * ATT_PITCH + (16 * blk) * 2 + 8 * trp;
    const int srow = tid >> 3, sch = tid & 7;
#define ATT_DECODE(u_, rowbase_, h_, r_, Q0_, S_, dlog_) do { int grp_, bh_, w_, L_; \
        if ((u_) < 3072) { grp_ = 0; bh_ = (u_) >> 5; w_ = (u_) & 31; L_ = LP; } else { grp_ = 1; const int r2_ = (u_) - 3072; bh_ = r2_ >> 4; w_ = r2_ & 15; L_ = LS; } \
        const int b_ = bh_ / 12; h_ = bh_ % 12; dlog_ = 2 * (h_ >> 2); S_ = L_ >> dlog_; const int upr_ = S_ >> 8; r_ = w_ / upr_; Q0_ = (w_ % upr_) * 256; \
        rowbase_ = grp_ ? MP + b_ * LS : b_ * LP; } while (0)
#define ATT_LOADKV(rowbase_, h_, r_, Q0_, S_, dlog_, KLO, VLO, VHI) do { _Pragma("unroll") for (int p = 0; p < 6; ++p) { int sk = (Q0_) - 64 + 64 * p + srow; sk = sk < 0 ? 0 : (sk >= (S_) ? (S_) - 1 : sk); \
        const bf16* rp = QKV + ((size_t)(rowbase_) + ((size_t)sk << (dlog_)) + (r_)) * QW + (h_) * 64 + sch * 8; if (p >= (KLO)) kr[p] = *(const v4u*)(rp + 768); if (p >= (VLO) && p < (VHI)) vr[p] = *(const v4u*)(rp + 1536); } } while (0)
    v4u kr[6], vr[6], qr[4];
#define ATT_LOADQ(rowbase_, h_, r_, Q0_, dlog_) load_raw(QKV + ((size_t)(rowbase_) + ((size_t)((Q0_) + 32 * wave + ql) << (dlog_)) + (r_)) * QW + (h_) * 64 + 8 * hi, qr)
    const int avid = (G % 8 == 0) ? (bid >> 3) + (G >> 3) * (bid & 7) : bid;
    if (avid < 4608) { int rb, h, r, Q0, S, dlog; ATT_DECODE(avid, rb, h, r, Q0, S, dlog); ATT_LOADKV(rb, h, r, Q0, S, dlog, 0, 0, 6); ATT_LOADQ(rb, h, r, Q0, dlog); }
    for (int u = avid; u < 4608; u += G) {
        int rowbase, h, r, Q0, S, dlog; ATT_DECODE(u, rowbase, h, r, Q0, S, dlog);
        const int g = h >> 2, hh = h & 3, K0 = Q0 - 64;

        { const f32x4 g0 = *(const f32x4*)(a.in[I_KNG] + h * 64 + sch * 8), g1 = *(const f32x4*)(a.in[I_KNG] + h * 64 + sch * 8 + 4);
#pragma unroll
          for (int p = 0; p < 6; ++p) { const int kl = 64 * p + srow, sk = K0 + kl; const bool valid = sk >= 0 && sk < S;
              const v4u r4 = kr[p]; float ss = 0.f;
#pragma unroll
              for (int w4 = 0; w4 < 4; ++w4) { const float lo = pg8::bf_lo(r4[w4]), hv = pg8::bf_hi(r4[w4]); ss += lo * lo + hv * hv; }
              ss += __shfl_xor(ss, 1); ss += __shfl_xor(ss, 2); ss += __shfl_xor(ss, 4);
              const float rstd = valid ? 1.0f / sqrtf(ss * (1.0f / 64.0f) + RMS_EPS) : 0.f;
              v4u o; o.x = pk2(pg8::bf_lo(r4.x) * rstd * g0.x, pg8::bf_hi(r4.x) * rstd * g0.y); o.y = pk2(pg8::bf_lo(r4.y) * rstd * g0.z, pg8::bf_hi(r4.y) * rstd * g0.w);
              o.z = pk2(pg8::bf_lo(r4.z) * rstd * g1.x, pg8::bf_hi(r4.z) * rstd * g1.y); o.w = pk2(pg8::bf_lo(r4.w) * rstd * g1.z, pg8::bf_hi(r4.w) * rstd * g1.w);
              *(LAS v4u*)(Ks + kl * ATT_PITCH + sch * 16) = o; *(LAS v4u*)(Vs + kl * ATT_PITCH + sch * 16) = vr[p]; }
        }
        const int q0 = Q0 + 32 * wave;
        bf16x8 qf[4];
        norm_frag(qr, a.in[I_QNG] + h * 64, 0.125f * 1.4426950408889634f, hi, true, qf);
        { const int un = u + G; if (un < 4608) { int rb, h2, r2, Q02, S2, dlog2; ATT_DECODE(un, rb, h2, r2, Q02, S2, dlog2); ATT_LOADKV(rb, h2, r2, Q02, S2, dlog2, 0, 0, 6); ATT_LOADQ(rb, h2, r2, Q02, dlog2); } }
        __syncthreads();
        f32x16 st[5];
#pragma unroll
        for (int j = 0; j < 5; ++j) {
            const LAS unsigned char* kp = Ks + (32 * wave + 32 * j + ql) * ATT_PITCH + (8 * hi) * 2;
            f32x16 acc;
#pragma unroll
            for (int i = 0; i < 16; ++i) acc[i] = 0.f;
#pragma unroll
            for (int kk = 0; kk < 4; ++kk) acc = MFMA32(*(const LAS bf16x8*)(kp + 32 * kk), qf[kk], acc);
            st[j] = acc;
        }
        const LAS float* btl = BT + h * ATT_BTW + 31 - ql + 4 * hi;
        const int vlo = K0 < 0 ? -K0 : 0, vhi = (S - K0) < 384 ? (S - K0) : 384;
        const int klb = 32 * wave + 4 * hi - vlo; const unsigned vspan = (unsigned)(vhi - vlo);
        float mx = -3.0e38f;
#pragma unroll
        for (int j = 0; j < 5; ++j)
#pragma unroll
            for (int i = 0; i < 16; ++i) {
                const int cji = 32 * j + (i & 3) + 8 * (i >> 2);
                float sv = st[j][i] + btl[cji];
                sv = ((unsigned)(klb + cji) < vspan) ? sv : -1.0e30f;
                st[j][i] = sv; mx = fmaxf(mx, sv);
            }
        mx = fmaxf(mx, __shfl_xor(mx, 32));
        float den = 0.f;
#pragma unroll
        for (int j = 0; j < 5; ++j)
#pragma unroll
            for (int i = 0; i < 16; ++i) { const float p = __builtin_amdgcn_exp2f(st[j][i] - mx); st[j][i] = p; den += p; }
        den += __shfl_xor(den, 32);
        f32x16 ot[2];
#pragma unroll
        for (int i = 0; i < 16; ++i) { ot[0][i] = 0.f; ot[1][i] = 0.f; }
#pragma unroll
        for (int j = 0; j < 5; ++j) {
#pragma unroll
            for (int kk2 = 0; kk2 < 2; ++kk2) {
                v4u pb; pb.x = pk2(st[j][8 * kk2 + 0], st[j][8 * kk2 + 1]); pb.y = pk2(st[j][8 * kk2 + 2], st[j][8 * kk2 + 3]);
                pb.z = pk2(st[j][8 * kk2 + 4], st[j][8 * kk2 + 5]); pb.w = pk2(st[j][8 * kk2 + 6], st[j][8 * kk2 + 7]);
                const bf16x8 pfrag = __builtin_bit_cast(bf16x8, pb);
#pragma unroll
                for (int dt = 0; dt < 2; ++dt) {
                    LAS unsigned char* tp = Vs + troff + (32 * j + 16 * kk2) * ATT_PITCH + (32 * dt) * 2;
                    const v4i16_t lo = __builtin_amdgcn_ds_read_tr16_b64_v4i16((LAS v4i16_t*)tp);
                    const v4i16_t hv = __builtin_amdgcn_ds_read_tr16_b64_v4i16((LAS v4i16_t*)(tp + 8 * ATT_PITCH));
                    const bf16x8 av = __builtin_shufflevector(lo, hv, 0, 1, 2, 3, 4, 5, 6, 7);
                    ot[dt] = MFMA32(av, pfrag, ot[dt]);
                }
            }
        }
        const float inv = 1.0f / den;
        const size_t orow = (size_t)rowbase + ((size_t)(q0 + ql) << dlog) + r;
        bf16* op = OG + ((size_t)g * MT + orow) * 256 + hh * 64;
#pragma unroll
        for (int dt = 0; dt < 2; ++dt)
#pragma unroll
            for (int pr = 0; pr < 2; ++pr) { const int ie = 2 * pr, io = 2 * pr + 1;
                const unsigned e0 = pk2(ot[dt][4 * ie] * inv, ot[dt][4 * ie + 1] * inv), e1 = pk2(ot[dt][4 * ie + 2] * inv, ot[dt][4 * ie + 3] * inv);
                const unsigned o0 = pk2(ot[dt][4 * io] * inv, ot[dt][4 * io + 1] * inv), o1 = pk2(ot[dt][4 * io + 2] * inv, ot[dt][4 * io + 3] * inv);
                const auto s0 = __builtin_amdgcn_permlane32_swap(e0, o0, false, false), s1 = __builtin_amdgcn_permlane32_swap(e1, o1, false, false);
                v4u w4; w4.x = s0[0]; w4.y = s1[0]; w4.z = s0[1]; w4.w = s1[1];
                *(v4u*)(op + 32 * dt + 8 * (2 * pr + hi)) = w4; }
        if (hi == 0) LSE[((size_t)g * MT + orow) * 4 + hh] = (mx + __log2f(den)) * 0.6931471805599453f;
        __syncthreads();
    }
}
__device__ __forceinline__ void merge_rows(const Args& a, int gw, int NGW, int lane) {
    const bf16* OG = (const bf16*)(a.ws + WS_OG); const float* LSE = (const float*)(a.ws + WS_LSE); bf16* YAT = (bf16*)(a.ws + WS_YAT);
    const int hh = lane >> 4;
    for (int mb = gw; mb < MT; mb += 4 * NGW) {
        float l[4][3]; v2u o[4][3];
#pragma unroll
        for (int r = 0; r < 4; ++r) { const int m = mb + r * NGW; const int mc = m < MT ? m : mb;
#pragma unroll
            for (int g = 0; g < 3; ++g) { l[r][g] = LSE[((size_t)g * MT + mc) * 4 + hh]; o[r][g] = *(const v2u*)(OG + ((size_t)g * MT + mc) * 256 + 4 * lane); } }
#pragma unroll
        for (int r = 0; r < 4; ++r) { const int m = mb + r * NGW; if (m < MT) {
            const float mxl = fmaxf(l[r][0], fmaxf(l[r][1], l[r][2]));
            float a0 = __expf(l[r][0] - mxl), a1 = __expf(l[r][1] - mxl), a2 = __expf(l[r][2] - mxl); const float is = 1.0f / (a0 + a1 + a2); a0 *= is; a1 *= is; a2 *= is;
            const v2u o0 = o[r][0], o1 = o[r][1], o2 = o[r][2];
            v2u w;
            w.x = pk2(a0 * pg8::bf_lo(o0.x) + a1 * pg8::bf_lo(o1.x) + a2 * pg8::bf_lo(o2.x), a0 * pg8::bf_hi(o0.x) + a1 * pg8::bf_hi(o1.x) + a2 * pg8::bf_hi(o2.x));
            w.y = pk2(a0 * pg8::bf_lo(o0.y) + a1 * pg8::bf_lo(o1.y) + a2 * pg8::bf_lo(o2.y), a0 * pg8::bf_hi(o0.y) + a1 * pg8::bf_hi(o1.y) + a2 * pg8::bf_hi(o2.y));
            *(v2u*)(YAT + (size_t)m * 256 + 4 * lane) = w; } }
    }
}

constexpr int HT_PITCH = 260;
constexpr int HW_OFF = 40960;
__device__ __forceinline__ void hy_weights_to_lds(const Args& a, LAS unsigned char* lds, int tid) {
    LAS float* W = (LAS float*)(lds + HW_OFF);
    for (int i = tid; i < 3 * ZW; i += 512) W[i] = a.in[I_CONVW][i];
    for (int i = tid; i < ZW; i += 512) W[3 * ZW + i] = a.in[I_CONVB][i];
    __syncthreads();
}
__device__ __forceinline__ void hy_load6(const bf16* ZHY, int col, int mr0, int L, v4u (&z)[6]) {
    const bool lv = (mr0 & (L - 1)) != 0, rv = ((mr0 + 4) & (L - 1)) != 0;
#pragma unroll
    for (int i = 0; i < 6; ++i) { const bool ok = (i == 0) ? lv : (i == 5 ? rv : true);
        v4u u = {0u, 0u, 0u, 0u}; if (ok) u = *(const v4u*)(ZHY + (size_t)(mr0 + i - 1) * ZW + col); z[i] = u; }
}
__device__ __forceinline__ void hy_conv4x8(const v4u (&z)[6], const LAS float* W, int col, float (&o)[4][8]) {
    float w0[8], w1[8], w2[8], bb[8];
#pragma unroll
    for (int h4 = 0; h4 < 2; ++h4) { const f32x4 a0 = *(const LAS f32x4*)(W + col + 4 * h4), a1 = *(const LAS f32x4*)(W + ZW + col + 4 * h4), a2 = *(const LAS f32x4*)(W + 2 * ZW + col + 4 * h4), a3 = *(const LAS f32x4*)(W + 3 * ZW + col + 4 * h4);
#pragma unroll
        for (int k = 0; k < 4; ++k) { w0[4 * h4 + k] = a0[k]; w1[4 * h4 + k] = a1[k]; w2[4 * h4 + k] = a2[k]; bb[4 * h4 + k] = a3[k]; } }
#pragma unroll
    for (int j = 0; j < 4; ++j)
#pragma unroll
        for (int k = 0; k < 4; ++k) {
            o[j][2 * k]     = pg8::bf_lo(z[j][k]) * w0[2 * k]     + pg8::bf_lo(z[j + 1][k]) * w1[2 * k]     + pg8::bf_lo(z[j + 2][k]) * w2[2 * k]     + bb[2 * k];
            o[j][2 * k + 1] = pg8::bf_hi(z[j][k]) * w0[2 * k + 1] + pg8::bf_hi(z[j + 1][k]) * w1[2 * k + 1] + pg8::bf_hi(z[j + 2][k]) * w2[2 * k + 1] + bb[2 * k + 1]; }
}
__device__ __forceinline__ void hyena_prep(const Args& a, LAS unsigned char* lds, int bid, int G, int tid) {
    const bf16* ZHY = (const bf16*)(a.ws + WS_ZHY); bf16* UCT = (bf16*)(a.ws + WS_UCT);
    LAS unsigned short* tile = (LAS unsigned short*)lds; const LAS float* W = (const LAS float*)(lds + HW_OFF);
    const int cg = tid & 7, tq = tid >> 3, NT = (MT / 256) * 12;
    hy_weights_to_lds(a, lds, tid);
    v4u n1[6], nv[6];
    if (bid < NT) { const int m0 = (bid / 12) * 256, c0 = (bid % 12) * 64, L = m0 < MP ? LP : LS; hy_load6(ZHY, 768 + c0 + 8 * cg, m0 + 4 * tq, L, n1); hy_load6(ZHY, 1536 + c0 + 8 * cg, m0 + 4 * tq, L, nv); }
    for (int it = bid; it < NT; it += G) {
        const int m0 = (it / 12) * 256, c0 = (it % 12) * 64, ca = c0 + 8 * cg;
        v4u z1[6], zv[6];
#pragma unroll
        for (int i = 0; i < 6; ++i) { z1[i] = n1[i]; zv[i] = nv[i]; }
        { const int itn = it + G; if (itn < NT) { const int m0n = (itn / 12) * 256, c0n = (itn % 12) * 64, Ln = m0n < MP ? LP : LS; hy_load6(ZHY, 768 + c0n + 8 * cg, m0n + 4 * tq, Ln, n1); hy_load6(ZHY, 1536 + c0n + 8 * cg, m0n + 4 * tq, Ln, nv); } }
        float x1[4][8], vv[4][8];
        hy_conv4x8(z1, W, 768 + ca, x1); hy_conv4x8(zv, W, 1536 + ca, vv);
#pragma unroll
        for (int i = 0; i < 8; ++i) { v2u w; w.x = pk2(x1[0][i] * vv[0][i], x1[1][i] * vv[1][i]); w.y = pk2(x1[2][i] * vv[2][i], x1[3][i] * vv[3][i]);
            *(LAS v2u*)(tile + (8 * cg + i) * HT_PITCH + 4 * tq) = w; }
        __syncthreads();
        { const int c = tid >> 3, piece = tid & 7;
          const LAS v2u* sp = (const LAS v2u*)(tile + c * HT_PITCH + piece * 32);
          v4u* dp = (v4u*)(UCT + (size_t)(c0 + c) * MT + m0 + piece * 32);
#pragma unroll
          for (int k = 0; k < 4; ++k) { const v2u lo = sp[2 * k], hv = sp[2 * k + 1]; v4u o; o.x = lo.x; o.y = lo.y; o.z = hv.x; o.w = hv.y; dp[k] = o; } }
        __syncthreads();
    }
}
__device__ __forceinline__ void hyena_gate(const Args& a, LAS unsigned char* lds, int bid, int G, int tid) {
    const bf16* ZHY = (const bf16*)(a.ws + WS_ZHY); const bf16* UCT = (const bf16*)(a.ws + WS_UCT); bf16* YH = (bf16*)(a.ws + WS_YH);
    LAS unsigned short* tile = (LAS unsigned short*)lds; const LAS float* W = (const LAS float*)(lds + HW_OFF);
    const int cg = tid & 7, tq = tid >> 3, NT = (MT / 256) * 12, yc = tid >> 3, yp = tid & 7;
    hy_weights_to_lds(a, lds, tid);
    v4u n0[6], ny[4];
    if (bid < NT) { const int m0 = (bid / 12) * 256, c0 = (bid % 12) * 64, L = m0 < MP ? LP : LS; hy_load6(ZHY, c0 + 8 * cg, m0 + 4 * tq, L, n0);
        const v4u* dp = (const v4u*)(UCT + (size_t)(c0 + yc) * MT + m0 + yp * 32);
#pragma unroll
        for (int k = 0; k < 4; ++k) ny[k] = dp[k]; }
    for (int it = bid; it < NT; it += G) {
        const int m0 = (it / 12) * 256, c0 = (it % 12) * 64, mr0 = m0 + 4 * tq, ca = c0 + 8 * cg;
        v4u z0[6];
#pragma unroll
        for (int i = 0; i < 6; ++i) z0[i] = n0[i];
        { LAS v2u* sp = (LAS v2u*)(tile + yc * HT_PITCH + yp * 32);
#pragma unroll
          for (int k = 0; k < 4; ++k) { const v4u o = ny[k]; v2u lo, hv; lo.x = o.x; lo.y = o.y; hv.x = o.z; hv.y = o.w; sp[2 * k] = lo; sp[2 * k + 1] = hv; } }
        { const int itn = it + G; if (itn < NT) { const int m0n = (itn / 12) * 256, c0n = (itn % 12) * 64, Ln = m0n < MP ? LP : LS; hy_load6(ZHY, c0n + 8 * cg, m0n + 4 * tq, Ln, n0);
            const v4u* dp = (const v4u*)(UCT + (size_t)(c0n + yc) * MT + m0n + yp * 32);
#pragma unroll
            for (int k = 0; k < 4; ++k) ny[k] = dp[k]; } }
        float x0[4][8];
        hy_conv4x8(z0, W, ca, x0);
        __syncthreads();
        float y[4][8];
#pragma unroll
        for (int i = 0; i < 8; ++i) { const v2u w = *(const LAS v2u*)(tile + (8 * cg + i) * HT_PITCH + 4 * tq);
            y[0][i] = pg8::bf_lo(w.x); y[1][i] = pg8::bf_hi(w.x); y[2][i] = pg8::bf_lo(w.y); y[3][i] = pg8::bf_hi(w.y); }
#pragma unroll
        for (int j = 0; j < 4; ++j) { v4u o;
#pragma unroll
            for (int k = 0; k < 4; ++k) o[k] = pk2(x0[j][2 * k] * y[j][2 * k], x0[j][2 * k + 1] * y[j][2 * k + 1]);
            *(v4u*)(YH + (size_t)(mr0 + j) * DH + ca) = o; }
        __syncthreads();
    }
}

#define FFT_LD(IDX) do { _Pragma("unroll") for (int e = 0; e < 32; ++e) v[e] = X[IDX(tl_, e)]; } while (0)
#define FFT_ST(IDX) do { _Pragma("unroll") for (int e = 0; e < 32; ++e) X[IDX(tl_, e)] = v[e]; } while (0)
#define FFT_PASS() const int tl_ = lnd(tid)
typedef cf2 f32x2v;
__device__ __forceinline__ int fft_pA(int t, int e) { return ((t ^ (t >> 5)) ^ (16 * (e & 1))) + 512 * e; }
__device__ __forceinline__ int fft_pB(int t, int e) { return ((t >> 4) << 9) + 32 * (e >> 1) + (((t & 15) ^ (e >> 1)) + 16 * ((e & 1) ^ ((t >> 4) & 1))); }
__device__ __forceinline__ int fft_pC(int t, int e) { return 32 * t + (e ^ (t & 31)); }
__device__ __forceinline__ void kraw_items(const Args& a, int gw, int NGW, int lane) {
    const float* H3 = (const float*)(a.ws + WS_H3); float* KR = (float*)(a.ws + WS_KRAW);
    for (int it = gw; it < 192 * 32; it += NGW) {
        const int pg = it >> 5, cgp = it & 31, p = pg * 64 + lane, c0 = cgp * 48;
        float h[64];
#pragma unroll
        for (int q = 0; q < 16; ++q) { const f32x4 t = *(const f32x4*)(H3 + (size_t)p * 64 + 4 * q); h[4 * q] = t.x; h[4 * q + 1] = t.y; h[4 * q + 2] = t.z; h[4 * q + 3] = t.w; }
        const int grp = p >= LP, tpos = p - grp * LP, L = grp ? LS : LP;
        const float tt = (float)tpos * (1.0f / (float)(L - 1));
#pragma unroll 1
        for (int cb = 0; cb < 4; ++cb) {
            const float* wr = a.in[I_FWOUT] + lane * 1536 + c0 + 12 * cb;
            const f32x4 w0 = *(const f32x4*)(wr), w1 = *(const f32x4*)(wr + 4), w2 = *(const f32x4*)(wr + 8);
            float wv[12] = {w0.x, w0.y, w0.z, w0.w, w1.x, w1.y, w1.z, w1.w, w2.x, w2.y, w2.z, w2.w};
#pragma unroll
            for (int ci = 0; ci < 12; ++ci) { const int c = c0 + 12 * cb + ci;
                float acc = 0.f;
#pragma unroll
                for (int jj = 0; jj < 64; ++jj) acc += h[jj] * __builtin_bit_cast(float, __builtin_amdgcn_readlane(__builtin_bit_cast(int, wv[ci]), jj));
                const int cm = c % 768;
                const float delta = fabsf(-3.0701134573253945f + (float)cm * ((-15.350567286626973f + 3.0701134573253945f) / 767.0f));
                KR[(size_t)c * (LP + LS) + p] = acc * __expf(-tt * delta); }
        }
    }
}
__device__ __forceinline__ void filter_phase(const Args& a, LAS unsigned char* lds, int bid, int G, int tid) {
    LAS f32x2v* X = (LAS f32x2v*)lds;
    LAS float* red = (LAS float*)(lds + 131072);
    const float* KR = (const float*)(a.ws + WS_KRAW);
    unsigned* KS = (unsigned*)(a.ws + WS_KSPEC);
    const int lane = tid & 63, wave = tid >> 6;
    for (int it = bid; it < 1536; it += G) {
        const int grp = it >= 768, c = it - grp * 768, L = grp ? LS : LP;
        const float* kf = KR + (size_t)c * (LP + LS) + grp * LP; const float* kb = kf + (size_t)768 * (LP + LS);
        cf2 v[32]; float asum = 0.f;
        { const int tl = lnd(tid);
#pragma unroll
          for (int e = 0; e < 32; ++e) {
            const int i = tl + 512 * e; float val = 0.f;
            if (e < 16) { if (i < L) val = kf[i]; } else { const int tp = 16384 - i; if (tp >= 1 && tp <= L - 1) val = kb[tp]; }
            v[e].x = val; v[e].y = 0.f; asum += fabsf(val);
          } }
        asum = wave_sum(asum);
        if (lane == 0) red[wave] = asum;
        __syncthreads();
        float tot = 0.f;
#pragma unroll
        for (int w = 0; w < 8; ++w) tot += red[w];
        const float sc = 1.0f / (tot * 16384.0f), dd = a.in[I_HYD][c] * (1.0f / 16384.0f);
        { FFT_PASS(); dif_stages<5, 0>(v, tl_, 9); FFT_ST(fft_pA); } __syncthreads();
        { FFT_PASS(); FFT_LD(fft_pB); dif_stages<5, 0>(v, tl_ & 15, 4); FFT_ST(fft_pB); } __syncthreads();
        { FFT_PASS(); FFT_LD(fft_pC); dif_stages<4, 0, true>(v, 0, 0); dif_stages<4, 16, true>(v, 0, 0);
          unsigned* kp = KS + (size_t)it * 16384 + tl_;
#pragma unroll
          for (int e = 0; e < 32; ++e) kp[e * 512] = pk2(v[e].x * sc + dd, v[e].y * sc); }
        __syncthreads();
    }
}
struct FftItem { int rowA, rowB, offB, kidx; unsigned short* base; };
__device__ __forceinline__ void fft_item(int it, bf16* UCT, FftItem& I, int& r0, int& r1, int& r2, int& r3, int& f1) {
    if (it < 3072) { const int c = it >> 2, bp = it & 3; r0 = (2 * bp) * LP; r1 = r0 + LP; r2 = r0 + 4096; r3 = r1 + 4096; f1 = 4096; I.kidx = c; I.base = UCT + (size_t)c * MT; }
    else { const int j = it - 3072, c = j >> 1, half = j & 1; r0 = MP + (4 * half) * LS; r1 = r0 + LS; r2 = r0 + 2 * LS; r3 = r2 + LS; f1 = 8192; I.kidx = 768 + c; I.base = UCT + (size_t)c * MT; }
}
__device__ __forceinline__ void fftconv_phase(const Args& a, LAS unsigned char* lds, int bid, int G, int tid) {
    LAS f32x2v* X = (LAS f32x2v*)lds;
    bf16* UCT = (bf16*)(a.ws + WS_UCT);
    const unsigned* KS = (const unsigned*)(a.ws + WS_KSPEC);
    const int vid = (G % 8 == 0) ? (bid >> 3) + (G >> 3) * (bid & 7) : bid;
    v4u nx[4];
    { FftItem I; int r0, r1, r2, r3, f1; if (vid < 4608) { fft_item(vid, UCT, I, r0, r1, r2, r3, f1); const int t8 = 8 * lnd(tid);
        nx[0] = *(const v4u*)(I.base + r0 + t8); nx[1] = *(const v4u*)(I.base + r1 + t8); nx[2] = *(const v4u*)(I.base + r2 + t8); nx[3] = *(const v4u*)(I.base + r3 + t8); } }
    for (int it = vid; it < 4608; it += G) {
        FftItem I; int r0, r1, r2, r3, f1; fft_item(it, UCT, I, r0, r1, r2, r3, f1);
        { const int tl = lnd(tid); const f32x2v z = {0.f, 0.f};
#pragma unroll
          for (int k = 0; k < 4; ++k) { f32x2v s0, s1, s2, s3;
              s0.x = pg8::bf_lo(nx[0][k]); s0.y = pg8::bf_lo(nx[1][k]); s1.x = pg8::bf_hi(nx[0][k]); s1.y = pg8::bf_hi(nx[1][k]);
              s2.x = pg8::bf_lo(nx[2][k]); s2.y = pg8::bf_lo(nx[3][k]); s3.x = pg8::bf_hi(nx[2][k]); s3.y = pg8::bf_hi(nx[3][k]);
              X[fft_swz(8 * tl + 2 * k)] = s0; X[fft_swz(8 * tl + 2 * k + 1)] = s1; X[fft_swz(f1 + 8 * tl + 2 * k)] = s2; X[fft_swz(f1 + 8 * tl + 2 * k + 1)] = s3; }
          const int z0 = (f1 == 4096) ? 8192 : 4096, z1 = 12288;
#pragma unroll
          for (int k = 0; k < 8; ++k) { X[fft_swz(z0 + tl + 512 * k)] = z; X[fft_swz(z1 + tl + 512 * k)] = z; } }
        { const int itn = it + G; if (itn < 4608) { FftItem J; int q0, q1, q2, q3, g1; fft_item(itn, UCT, J, q0, q1, q2, q3, g1); const int t8 = 8 * lnd(tid);
            nx[0] = *(const v4u*)(J.base + q0 + t8); nx[1] = *(const v4u*)(J.base + q1 + t8); nx[2] = *(const v4u*)(J.base + q2 + t8); nx[3] = *(const v4u*)(J.base + q3 + t8); } }
        __syncthreads();
        cf2 v[32];
        { FFT_PASS(); FFT_LD(fft_pA); dif_stages<5, 0>(v, tl_, 9); FFT_ST(fft_pA); } __syncthreads();
        unsigned kq[32];
        { const unsigned* kp = KS + (size_t)I.kidx * 16384 + lnd(tid);
#pragma unroll
          for (int e = 0; e < 32; ++e) kq[e] = kp[e * 512]; }
        { FFT_PASS(); FFT_LD(fft_pB); dif_stages<5, 0>(v, tl_ & 15, 4); FFT_ST(fft_pB); } __syncthreads();
        { FFT_PASS(); FFT_LD(fft_pC); dif_stages<4, 0, true>(v, 0, 0); dif_stages<4, 16, true>(v, 0, 0);
#pragma unroll
          for (int e = 0; e < 32; ++e) { f32x2v kk; kk.x = pg8::bf_lo(kq[e]); kk.y = pg8::bf_hi(kq[e]); v[e] = cmul(v[e], kk); }
          dit_stages<4, 0, true>(v, 0, 0); dit_stages<4, 16, true>(v, 0, 0); FFT_ST(fft_pC); } __syncthreads();
        { FFT_PASS(); FFT_LD(fft_pB); dit_stages<5, 0>(v, tl_ & 15, 4); FFT_ST(fft_pB); } __syncthreads();
        { FFT_PASS(); FFT_LD(fft_pA); dit_stages<5, 0>(v, tl_, 9); FFT_ST(fft_pA); } __syncthreads();
        { const int tl = lnd(tid); v4u o0, o1, o2, o3;
#pragma unroll
          for (int k = 0; k < 4; ++k) { const f32x2v s0 = X[fft_swz(8 * tl + 2 * k)], s1 = X[fft_swz(8 * tl + 2 * k + 1)], s2 = X[fft_swz(f1 + 8 * tl + 2 * k)], s3 = X[fft_swz(f1 + 8 * tl + 2 * k + 1)];
              o0[k] = pk2(s0.x, s1.x); o1[k] = pk2(s0.y, s1.y); o2[k] = pk2(s2.x, s3.x); o3[k] = pk2(s2.y, s3.y); }
          *(v4u*)(I.base + r0 + 8 * tl) = o0; *(v4u*)(I.base + r1 + 8 * tl) = o1; *(v4u*)(I.base + r2 + 8 * tl) = o2; *(v4u*)(I.base + r3 + 8 * tl) = o3; }
        __syncthreads();
    }
}

#define XB_TMO      128
#define XB_XCNT(j)  (256  + 64 * (j))
#define XB_XSUB(j)  (1280 + 64 * (j))
#define XB_XGEN(j)  (2304 + 64 * (j))
#define XB_TOP      3328
#define XB_TOPGEN   3392
#define XCD_BAR_WORDS 3456
#define XB_SPIN_CAP (1u << 18)

__device__ __forceinline__ unsigned xb_ld(unsigned* p)              { return __hip_atomic_load(p, __ATOMIC_RELAXED, __HIP_MEMORY_SCOPE_AGENT); }
__device__ __forceinline__ unsigned xb_add(unsigned* p, unsigned v) { return __hip_atomic_fetch_add(p, v, __ATOMIC_RELAXED, __HIP_MEMORY_SCOPE_AGENT); }
__device__ __forceinline__ unsigned xb_xcc_id() { return (unsigned)__builtin_amdgcn_s_getreg((3 << 11) | 20) & 0xFu; }
#define XB_SPIN(cond, bar) do { unsigned _sp = 0; while (cond) { __builtin_amdgcn_s_sleep(1); \
    if ((++_sp & 255u) == 0u) { if (xb_ld(&(bar)[XB_TMO])) break; if (_sp > XB_SPIN_CAP) { atomicAdd(&(bar)[XB_TMO], 1u); break; } } } } while (0)

struct XcdBarrier {
    unsigned* bar; unsigned x;
    volatile LAS unsigned* st;
};

__device__ __forceinline__ XcdBarrier xcd_barrier_post(unsigned* bar, volatile LAS unsigned* st) {
    XcdBarrier b; b.bar = bar; b.x = xb_xcc_id(); b.st = st;
    if (threadIdx.x == 0) (void)xb_add(&bar[XB_XCNT(b.x)], 1u);
    return b;
}
__device__ __forceinline__ void xcd_barrier_complete(unsigned* bar, unsigned x, unsigned& nloc, unsigned& nx) {
    const unsigned G = gridDim.x * gridDim.y * gridDim.z;
    unsigned sum, cnt, mine, sp = 0u;
    for (;;) {
        sum = 0u; cnt = 0u; mine = 0u;
#pragma unroll
        for (unsigned j = 0; j < 16; ++j) { const unsigned c = xb_ld(&bar[XB_XCNT(j)]); sum += c; cnt += (c > 0u) ? 1u : 0u; mine = (j == x) ? c : mine; }
        if (sum == G) break;
        __builtin_amdgcn_s_sleep(1);
        if ((++sp & 255u) == 0u) { if (xb_ld(&bar[XB_TMO])) break; if (sp > XB_SPIN_CAP) { atomicAdd(&bar[XB_TMO], 1u); break; } }
    }
    nloc = mine > 0u ? mine : 1u; nx = cnt > 0u ? cnt : 1u;
}

__device__ __forceinline__ void xcd_barrier(const XcdBarrier& b) {
    asm volatile("s_waitcnt vmcnt(0)" ::: "memory");
    __syncthreads();
    if (threadIdx.x == 0) {
        unsigned* bar = b.bar;
        __builtin_amdgcn_s_waitcnt(0);
        unsigned nloc = b.st[0], nx = b.st[1];
        if (nloc == 0u) { xcd_barrier_complete(bar, b.x, nloc, nx); b.st[0] = nloc; b.st[1] = nx; }
        const unsigned old = xb_add(&bar[XB_XSUB(b.x)], 1u);
        const unsigned gen = old / nloc;
        if (old + 1u == (gen + 1u) * nloc) {
            __builtin_amdgcn_fence(__ATOMIC_RELEASE, "agent");
            asm volatile("s_waitcnt vmcnt(0)" ::: "memory");
            const unsigned og = xb_add(&bar[XB_TOP], 1u);
            const unsigned tg = og / nx;
            if (og + 1u == (tg + 1u) * nx) xb_add(&bar[XB_TOPGEN], 1u);
            else XB_SPIN(xb_ld(&bar[XB_TOPGEN]) == tg, bar);
            __builtin_amdgcn_fence(__ATOMIC_ACQUIRE, "agent");
            xb_add(&bar[XB_XGEN(b.x)], 1u);
            asm volatile("s_waitcnt vmcnt(0)" ::: "memory");
        } else {
            XB_SPIN(xb_ld(&bar[XB_XGEN(b.x)]) == gen, bar);
            __builtin_amdgcn_fence(__ATOMIC_ACQUIRE, "agent");
            asm volatile("s_waitcnt vmcnt(0)" ::: "memory");
        }
    }
    __syncthreads();
}

template <int PHM> __global__ void __launch_bounds__(512, 2) mk_fwd(Args karg) {
    extern __shared__ __attribute__((aligned(16))) unsigned char lds_raw[];
    LAS unsigned char* lds = (LAS unsigned char*)lds_raw;
    const int bid = blockIdx.x, G = gridDim.x, NGW = G * 8;
#define PH_IDS() const int tid = lnd((int)threadIdx.x), lane = tid & 63, wave = __builtin_amdgcn_readfirstlane(tid >> 6), gw = bid * 8 + wave; (void)lane; (void)gw
    typedef const __attribute__((address_space(4))) Args* KArgs;
    KArgs kp = (KArgs)__builtin_amdgcn_kernarg_segment_ptr();
#define PH_ARGS() KArgs kq_ = kp; asm volatile("" : "+s"(kq_)); const Args a = *(const Args*)kq_; unsigned char* ws = a.ws; const float* MOD = (const float*)(ws + WS_MOD); \
    bf16* WIN = (bf16*)(ws + WS_WIN); bf16* WHB = (bf16*)(ws + WS_WHB); bf16* WAB = (bf16*)(ws + WS_WAB); bf16* WOUT = (bf16*)(ws + WS_WOUT); bf16* WUP = (bf16*)(ws + WS_WUP); bf16* WDN = (bf16*)(ws + WS_WDN); \
    (void)MOD; (void)WIN; (void)WHB; (void)WAB; (void)WOUT; (void)WUP; (void)WDN
    constexpr bool MULTI = (PHM & (PHM - 1)) != 0;
    XcdBarrier xbar; xbar.bar = (unsigned*)(karg.ws + WS_BAR); xbar.x = 0; xbar.st = nullptr;
    if constexpr (MULTI) {
        volatile LAS unsigned* stw = (volatile LAS unsigned*)(lds + LDS_BYTES - 64);
        if (threadIdx.x < 2) stw[threadIdx.x] = 0u;
        __syncthreads();
        xbar = xcd_barrier_post((unsigned*)(karg.ws + WS_BAR), stw);
    }
#define GRID_SYNC(k) do { if constexpr (MULTI) { if ((k) == 0) cg::this_grid().sync(); else xcd_barrier(xbar); } } while (0)
#define IN(k) (((PHM >> (k)) & 1) && karg.ph_lo <= (k) && (k) < karg.ph_hi)
#ifndef REP_MASK
#define REP_MASK 0
#endif
#define REPS(k) for (int rep_ = 0; rep_ < (((REP_MASK >> (k)) & 1) ? 2 : 1); ++rep_)
#define SEAM(k) do { if (IN(k) && IN((k) + 1)) GRID_SYNC(k); } while (0)

    if (IN(0)) REPS(0) { PH_ARGS(); PH_IDS();
        p0_mod(a, lds, bid, G, tid);
        LAS float* scr = (LAS float*)(lds + wave * 16384);
        constexpr int I_IN = (DM / 64) * (NIN / 32), I_HB = (DH / 64) * (DM / 32), I_AB = (256 / 64) * (DM / 32), I_OUT = (DM / 64) * (DM / 32), I_UP = (DM / 64) * (DFF / 32), I_DN = (DFF / 64) * (DM / 32);
        constexpr int NITEMS = I_IN + I_HB + I_AB + I_OUT + I_UP + I_DN;
        for (int it = gw; it < NITEMS; it += NGW) {
            int r = it;
            if (r < I_IN) { const int n0 = 32 * (r % (NIN / 32)); const int off = n0 < 2304 ? 3072 : (n0 < 5376 ? -2304 : 0);
                p0_transpose_item(a.in[I_WIN], DM, NIN, WIN, off, scr, r, lane); continue; } r -= I_IN;
            if (r < I_HB) { p0_transpose_item(a.in[I_WHB], DH, DM, WHB, 0, scr, r, lane); continue; } r -= I_HB;
            if (r < I_AB) { p0_transpose_item(a.in[I_WAB], 256, DM, WAB, 0, scr, r, lane); continue; } r -= I_AB;
            if (r < I_OUT) { p0_transpose_item(a.in[I_WOUT], DM, DM, WOUT, 0, scr, r, lane); continue; } r -= I_OUT;
            if (r < I_UP) { p0_transpose_item(a.in[I_WUP], DM, DFF, WUP, 0, scr, r, lane); continue; } r -= I_UP;
            p0_transpose_item(a.in[I_WDN], DFF, DM, WDN, 0, scr, r, lane);
        }
        p0_h3(a, gw, NGW, lane);
        __syncthreads();
    }
    SEAM(0);
    if (IN(1)) REPS(1) { PH_ARGS(); PH_IDS(); prep_rows<false>(a.in[I_XP], a.in[I_XS], nullptr, a.in[I_N1G], MOD, 0, 1024, (bf16*)(ws + WS_U1), gw, NGW, lane); kraw_items(a, gw, NGW, lane); }
    SEAM(1);
    if (IN(2)) REPS(2) { PH_ARGS();
        pg8::Gemm g{(const bf16*)(ws + WS_U1), WIN, MT, QW + 768, DM}; pg8::StaticOrder S; S.init(MT, QW + 768, G, bid);
        pg8::EpiB<1> E{(bf16*)(ws + WS_QKV), QW, nullptr, (bf16*)a.out, QW / 256, 0};
        pg8::gemm_phase<pg8::EpiB<1>, pg8::StaticOrder, GEMM_ALIGN, GEMM_SP2>(lds, g, S, E);
    }
    SEAM(2);
    if (IN(3)) REPS(3) { PH_ARGS(); PH_IDS(); attn_phase(a, lds, bid, G, tid); __syncthreads(); }
    SEAM(3);
    if (IN(4)) REPS(4) { PH_ARGS(); { PH_IDS();
        merge_rows(a, gw, NGW, lane); }
        pg8::Gemm g{(const bf16*)(ws + WS_U1), WIN + (size_t)3072 * DM, MT, ZW + GW - 768, DM}; pg8::StaticOrder S; S.init(MT, ZW + GW - 768, G, bid);
        pg8::EpiB<1> E{(bf16*)(ws + WS_ZHY), ZW, nullptr, (bf16*)a.out, ZW / 256, 768};
        pg8::gemm_phase<pg8::EpiB<1>, pg8::StaticOrder, GEMM_ALIGN, GEMM_SP2>(lds, g, S, E);
    }
    SEAM(4);
    if (IN(5)) REPS(5) { PH_ARGS(); PH_IDS(); hyena_prep(a, lds, bid, G, tid); filter_phase(a, lds, bid, G, tid); }
    SEAM(5);
    if (IN(6)) REPS(6) { PH_ARGS(); PH_IDS(); fftconv_phase(a, lds, bid, G, tid); }
    SEAM(6);
    if (IN(7)) REPS(7) { PH_ARGS(); PH_IDS(); hyena_gate(a, lds, bid, G, tid); }
    SEAM(7);
    if (IN(8)) REPS(8) { PH_ARGS();
        pg8::Gemm g{(const bf16*)(ws + WS_YH), WHB, MT, DM, DH}; pg8::StaticOrder S; S.init(MT, DM, G, bid);
        pg8::EpiB<2> E{(bf16*)(ws + WS_T1), DM, (const bf16*)a.out, (bf16*)(ws + WS_T1L), 0};
        pg8::gemm_phase<pg8::EpiB<2>, pg8::StaticOrder, GEMM_ALIGN, GEMM_SP2>(lds, g, S, E);
    }
    if (IN(9)) REPS(9) { PH_ARGS();
        pg8::Gemm g{(const bf16*)(ws + WS_YAT), WAB, MT, DM, 256}; pg8::StaticOrder S; S.init(MT, DM, G, bid);
        pg8::EpiB<3> E{(bf16*)(ws + WS_T1), DM, (const bf16*)a.out, (bf16*)(ws + WS_T1L), 0};
        pg8::gemm_phase<pg8::EpiB<3>, pg8::StaticOrder, GEMM_ALIGN, GEMM_SP2>(lds, g, S, E);
    }
    SEAM(9);
    if (IN(10)) REPS(10) { PH_ARGS();
        pg8::Gemm g{(const bf16*)(ws + WS_T1), WOUT, MT, DM, DM}; pg8::StaticOrder S; S.init(MT, DM, G, bid);
        pg8::EpiH E{a.in[I_XP], a.in[I_XS], (bf16*)(ws + WS_H16), MOD + 2048};
        pg8::gemm_phase<pg8::EpiH, pg8::StaticOrder, GEMM_ALIGN, GEMM_SP2>(lds, g, S, E);
    }
    SEAM(10);
    if (IN(11)) REPS(11) { PH_ARGS(); PH_IDS(); prep_rows<true>(nullptr, nullptr, (const bf16*)(ws + WS_H16), a.in[I_N2G], MOD, 3072, 4096, (bf16*)(ws + WS_U2), gw, NGW, lane); }
    SEAM(11);
#define MLP_HALF(kup, kdn, half) \
    if (IN(kup)) REPS(kup) { PH_ARGS(); \
        pg8::Gemm g{(const bf16*)(ws + WS_U2) + (size_t)(half) * (MT / 2) * DM, WUP, MT / 2, DFF, DM}; pg8::StaticOrder S; S.init(MT / 2, DFF, G, bid); \
        pg8::EpiB<5> E{(bf16*)(ws + WS_FF), DFF, nullptr, nullptr, 0}; \
        pg8::gemm_phase<pg8::EpiB<5>, pg8::StaticOrder, GEMM_ALIGN, GEMM_SP2>(lds, g, S, E); \
    } \
    SEAM(kup); \
    if (IN(kdn)) REPS(kdn) { PH_ARGS(); \
        pg8::Gemm g{(const bf16*)(ws + WS_FF), WDN, MT / 2, DM, DFF}; pg8::StaticOrder S; S.init(MT / 2, DM, G, bid); \
        pg8::EpiF E{(const bf16*)(ws + WS_H16), a.out, MOD + 5120, (half) * (MT / 2)}; \
        pg8::gemm_phase<pg8::EpiF, pg8::StaticOrder, GEMM_ALIGN, GEMM_SP2>(lds, g, S, E); \
    }
    MLP_HALF(12, 13, 0)
    SEAM(13);
    MLP_HALF(14, 15, 1)
}

extern "C" void kernel_launch(void* const* d_in, const int* in_sizes, int n_in, void* d_out, int out_size, void* d_ws, size_t ws_size, hipStream_t stream) {
    static int grid = 0;
    if (grid == 0) {
        if (n_in != 28 || in_sizes[0] != MP * DM || in_sizes[1] != MS * DM || out_size != MT * DM || ws_size < WS_END) {
            fprintf(stderr, "kernel_launch: unexpected shapes (n_in %d, in0 %d, out %d, ws %zu); nothing launched\n", n_in, n_in > 0 ? in_sizes[0] : -1, out_size, ws_size); grid = -1; return; }
        int dev = 0, cus = 0, per_cu = 0;
        if (hipGetDevice(&dev) != hipSuccess || hipDeviceGetAttribute(&cus, hipDeviceAttributeMultiprocessorCount, dev) != hipSuccess) { grid = -1; return; }
#if MK_PER_PHASE
        const void* fns[NPHASE] = {(const void*)mk_fwd<1>, (const void*)mk_fwd<2>, (const void*)mk_fwd<4>, (const void*)mk_fwd<8>, (const void*)mk_fwd<16>, (const void*)mk_fwd<32>, (const void*)mk_fwd<64>, (const void*)mk_fwd<128>,
                                   (const void*)mk_fwd<256>, (const void*)mk_fwd<512>, (const void*)mk_fwd<1024>, (const void*)mk_fwd<2048>, (const void*)mk_fwd<4096>, (const void*)mk_fwd<8192>, (const void*)mk_fwd<16384>, (const void*)mk_fwd<32768>};
        for (int p = 0; p < NPHASE; ++p) if (hipFuncSetAttribute(fns[p], hipFuncAttributeMaxDynamicSharedMemorySize, LDS_BYTES) != hipSuccess) { fprintf(stderr, "kernel_launch: hipFuncSetAttribute failed\n"); grid = -1; return; }
#else
        if (hipFuncSetAttribute((const void*)mk_fwd<0xffff>, hipFuncAttributeMaxDynamicSharedMemorySize, LDS_BYTES) != hipSuccess) { fprintf(stderr, "kernel_launch: hipFuncSetAttribute failed\n"); grid = -1; return; }
        if (hipOccupancyMaxActiveBlocksPerMultiprocessor(&per_cu, (const void*)mk_fwd<0xffff>, 512, LDS_BYTES) != hipSuccess || per_cu < 1) { fprintf(stderr, "kernel_launch: occupancy query says %d\n", per_cu); per_cu = 1; }
#endif
        (void)per_cu; (void)hipGetLastError();
        grid = cus * 1;
    }
    if (grid < 0) return;
    Args a{};
    for (int i = 0; i < 28; ++i) a.in[i] = (const float*)d_in[i];
    a.out = (float*)d_out; a.ws = (unsigned char*)d_ws;
#if MK_PER_PHASE
#ifndef HOST_REP_MASK
#define HOST_REP_MASK 0
#endif
#define LAUNCH_P(p) do { a.ph_lo = (p); a.ph_hi = (p) + 1; for (int r_ = 0; r_ < (((HOST_REP_MASK >> (p)) & 1) ? 2 : 1); ++r_) hipLaunchKernelGGL(mk_fwd<(1 << (p))>, dim3(grid), dim3(512), LDS_BYTES, stream, a); } while (0)
    LAUNCH_P(0); LAUNCH_P(1); LAUNCH_P(2); LAUNCH_P(3); LAUNCH_P(4); LAUNCH_P(5); LAUNCH_P(6); LAUNCH_P(7); LAUNCH_P(8); LAUNCH_P(9); LAUNCH_P(10); LAUNCH_P(11); LAUNCH_P(12); LAUNCH_P(13); LAUNCH_P(14); LAUNCH_P(15);
#else
    a.ph_lo = 0; a.ph_hi = NPHASE;
    if (hipMemsetAsync((char*)d_ws + WS_BAR, 0, XCD_BAR_WORDS * 4, stream) != hipSuccess) { fprintf(stderr, "kernel_launch: memset of the barrier words failed\n"); return; }
    void* args[] = {&a};
    hipError_t e = hipLaunchCooperativeKernel((const void*)mk_fwd<0xffff>, dim3(grid), dim3(512), args, LDS_BYTES, stream);
    if (e != hipSuccess) fprintf(stderr, "cooperative launch failed: %s (grid %d)\n", hipGetErrorString(e), grid);
#endif
}
```
